# Optimizing an MI355X kernel written in HIP

```python
import math
import jax, jax.numpy as jnp
from jax import lax
import numpy as np

D_MODEL = 2048
BATCH = 4
SEQ = 4096
DEPTH = 1

MEM_LEN = 256
LN_EPS = 1e-5
GLA_HEADS = 4
GLA_DV = (D_MODEL // 2) // GLA_HEADS
GLA_DK = GLA_DV // 2
GLA_GATE_RANK = 16
GLA_TAU = 16.0
GLA_CHUNK = 64
DIL_HD = 128
DIL_HEADS = (D_MODEL // 2) // DIL_HD
DIL_PATTERNS = ((128, 1), (512, 4), (2048, 16))
ROPE_THETA = 500000.0
ROPE_DIMS = DIL_HD // 4
CA_HEADS = 4
CA_HD = D_MODEL // CA_HEADS
D_FF = 5504
CONV_W = 3
DEEPNORM_ALPHA = (2.0 * DEPTH) ** 0.25
DEEPNORM_BETA = (8.0 * DEPTH) ** -0.25
IN_WIDTHS = (GLA_HEADS * GLA_DK, GLA_HEADS * GLA_DK, GLA_HEADS * GLA_DV, GLA_HEADS * GLA_DV,
             GLA_GATE_RANK, DIL_HEADS * DIL_HD, DIL_HEADS * DIL_HD, DIL_HEADS * DIL_HD)
IN_COLS = sum(IN_WIDTHS)
MIX_WIDTH = GLA_HEADS * GLA_DV + DIL_HEADS * DIL_HD

kernel_name = "hybrid_gla_dilated_attn_deepnorm_layer"


def split_cols(h, widths):
    outs, start = [], 0
    for w in widths:
        outs.append(h[..., start:start + w])
        start += w
    return outs


def layer_norm(x, g, b):
    xf = x.astype(jnp.float32)
    mu = jnp.mean(xf, axis=-1, keepdims=True)
    var = jnp.mean(jnp.square(xf - mu), axis=-1, keepdims=True)
    y = (xf - mu) * lax.rsqrt(var + LN_EPS)
    return (y * g.astype(jnp.float32) + b.astype(jnp.float32)).astype(x.dtype)


def partial_rotary(t, cos, sin):
    half = ROPE_DIMS // 2
    t1 = t[..., :half].astype(jnp.float32)
    t2 = t[..., half:ROPE_DIMS].astype(jnp.float32)
    rot = jnp.concatenate([t1 * cos - t2 * sin, t2 * cos + t1 * sin], axis=-1)
    return jnp.concatenate([rot.astype(t.dtype), t[..., ROPE_DIMS:]], axis=-1)


def gla_chunked(q, k, v, log_g):
    B, S, H, dk = q.shape
    dv = v.shape[-1]
    C = GLA_CHUNK
    N = S // C

    def chunk(t):
        return t.astype(jnp.float32).reshape(B, N, C, H, -1).transpose(0, 3, 1, 2, 4)

    qc = chunk(q) * (dk ** -0.5)
    kc, vc, gc = chunk(k), chunk(v), chunk(log_g)
    b = lax.cumsum(gc, axis=3)
    b_last = b[:, :, :, -1:, :]
    q_in = qc * jnp.exp(b)
    k_in = kc * jnp.exp(-b)
    k_end = kc * jnp.exp(b_last - b)
    causal = jnp.tril(jnp.ones((C, C), dtype=bool))
    A = jnp.where(causal, jnp.einsum('bhnik,bhnjk->bhnij', q_in, k_in), 0.0)
    o = jnp.einsum('bhnij,bhnjv->bhniv', A, vc)
    dS = jnp.einsum('bhnjk,bhnjv->bhnkv', k_end, vc)
    decay = jnp.exp(b_last[:, :, :, 0, :])

    def step(state, inp):
        dec, ds = inp
        return dec[..., None] * state + ds, state

    _, s_before = lax.scan(step, jnp.zeros((B, H, dk, dv), jnp.float32),
                           (jnp.moveaxis(decay, 2, 0), jnp.moveaxis(dS, 2, 0)))
    s_before = jnp.moveaxis(s_before, 0, 2)
    o = o + jnp.einsum('bhnik,bhnkv->bhniv', q_in, s_before)
    return o.transpose(0, 2, 3, 1, 4).reshape(B, S, H, dv)


def dilated_branch(q, k, v, window, dilation):
    B, S, H, hd = q.shape
    L = S // dilation
    band = window // dilation
    nb = -(-L // band)
    Lp = nb * band

    def to_sub(t):
        t = t.reshape(B, L, dilation, H, hd).transpose(0, 2, 3, 1, 4)
        t = jnp.pad(t, ((0, 0), (0, 0), (0, 0), (0, Lp - L), (0, 0)))
        return t.reshape(B, dilation, H, nb, band, hd)

    def with_prev(t):
        prev = jnp.pad(t[:, :, :, :-1], ((0, 0), (0, 0), (0, 0), (1, 0), (0, 0), (0, 0)))
        return jnp.concatenate([prev, t], axis=4)

    qb = to_sub(q)
    kk = with_prev(to_sub(k))
    vv = with_prev(to_sub(v))
    s = jnp.einsum('bdhnqc,bdhnkc->bdhnqk', qb, kk).astype(jnp.float32)
    qi = jnp.arange(band)[:, None] + band
    kj = jnp.arange(2 * band)[None, :]
    diff = qi - kj
    blk = jnp.arange(nb)[:, None, None]
    mask = (diff >= 0) & (diff <= band) & ((blk > 0) | (kj >= band))
    s = jnp.where(mask, s, -jnp.inf)
    m = jnp.max(s, axis=-1, keepdims=True)
    p = jnp.exp(s - m)
    den = jnp.sum(p, axis=-1, keepdims=True)
    o = jnp.einsum('bdhnqk,bdhnkc->bdhnqc', p.astype(v.dtype), vv).astype(jnp.float32) / den
    lse = (m + jnp.log(den))[..., 0]
    o = o.reshape(B, dilation, H, Lp, hd)[:, :, :, :L].transpose(0, 3, 1, 2, 4).reshape(B, S, H, hd)
    lse = lse.reshape(B, dilation, H, Lp)[:, :, :, :L].transpose(0, 3, 1, 2).reshape(B, S, H)
    return o, lse


def dilated_attention(q, k, v):
    outs, lses = [], []
    for window, dilation in DIL_PATTERNS:
        o, lse = dilated_branch(q, k, v, window, dilation)
        outs.append(o)
        lses.append(lse)
    w = jax.nn.softmax(jnp.stack(lses, axis=0), axis=0)
    return jnp.sum(w[..., None] * jnp.stack(outs, axis=0), axis=0)


def causal_dwconv(u, w, b):
    S = u.shape[1]
    up = jnp.pad(u, ((0, 0), (CONV_W - 1, 0), (0, 0)))
    y = b + w[0] * up[:, 0:S]
    for i in range(1, CONV_W):
        y = y + w[i] * up[:, i:i + S]
    return y


def setup_inputs(seed: int = 0) -> dict:
    key = jax.random.key(seed)
    ks = jax.random.split(key, 24)
    f32 = jnp.float32
    nrm = lambda k, shape, std: jax.random.normal(k, shape, f32) * std
    beta = DEEPNORM_BETA
    x = jax.random.normal(ks[0], (BATCH, SEQ, D_MODEL), f32)
    mem = jax.random.normal(ks[1], (BATCH, MEM_LEN, D_MODEL), f32)
    offs = jax.random.randint(ks[2], (BATCH, 1), 0, 4096, dtype=jnp.int32)
    positions = offs + jnp.arange(SEQ, dtype=jnp.int32)[None, :]
    col_scale = jnp.concatenate([jnp.full((w,), beta if i in (2, 7) else 1.0, f32)
                                 for i, w in enumerate(IN_WIDTHS)])
    w_in = nrm(ks[3], (DEPTH, D_MODEL, IN_COLS), D_MODEL ** -0.5) * col_scale
    gla_gate_w2 = nrm(ks[4], (DEPTH, GLA_GATE_RANK, GLA_HEADS * GLA_DK), GLA_GATE_RANK ** -0.5)
    gla_gate_b = nrm(ks[5], (DEPTH, GLA_HEADS * GLA_DK), 0.01)
    gla_norm_g = 1.0 + nrm(ks[6], (DEPTH, GLA_HEADS * GLA_DV), 0.02)
    w_out = nrm(ks[7], (DEPTH, MIX_WIDTH, D_MODEL), MIX_WIDTH ** -0.5) * beta
    ln1_g = 1.0 + nrm(ks[8], (DEPTH, D_MODEL), 0.02)
    ln1_b = nrm(ks[9], (DEPTH, D_MODEL), 0.02)
    ca_wq = nrm(ks[10], (DEPTH, D_MODEL, D_MODEL), D_MODEL ** -0.5)
    kv_scale = jnp.concatenate([jnp.ones((D_MODEL,), f32), jnp.full((D_MODEL,), beta, f32)])
    ca_wkv = nrm(ks[11], (DEPTH, D_MODEL, 2 * D_MODEL), D_MODEL ** -0.5) * kv_scale
    ca_wo = nrm(ks[12], (DEPTH, D_MODEL, D_MODEL), D_MODEL ** -0.5) * beta
    ln2_g = 1.0 + nrm(ks[13], (DEPTH, D_MODEL), 0.02)
    ln2_b = nrm(ks[14], (DEPTH, D_MODEL), 0.02)
    ffn_w_in = nrm(ks[15], (DEPTH, D_MODEL, 2 * D_FF), D_MODEL ** -0.5) * beta
    ffn_conv_w = nrm(ks[16], (DEPTH, CONV_W, 2 * D_FF), CONV_W ** -0.5)
    ffn_conv_b = nrm(ks[17], (DEPTH, 2 * D_FF), 0.02)
    ffn_w_out = nrm(ks[18], (DEPTH, D_FF, D_MODEL), D_FF ** -0.5) * beta
    ln3_g = 1.0 + nrm(ks[19], (DEPTH, D_MODEL), 0.02)
    ln3_b = nrm(ks[20], (DEPTH, D_MODEL), 0.02)
    return {"x": x, "mem": mem, "positions": positions, "w_in": w_in,
            "gla_gate_w2": gla_gate_w2, "gla_gate_b": gla_gate_b, "gla_norm_g": gla_norm_g,
            "w_out": w_out, "ln1_g": ln1_g, "ln1_b": ln1_b,
            "ca_wq": ca_wq, "ca_wkv": ca_wkv, "ca_wo": ca_wo, "ln2_g": ln2_g, "ln2_b": ln2_b,
            "ffn_w_in": ffn_w_in, "ffn_conv_w": ffn_conv_w, "ffn_conv_b": ffn_conv_b,
            "ffn_w_out": ffn_w_out, "ln3_g": ln3_g, "ln3_b": ln3_b}


def reference(x, mem, positions, w_in, gla_gate_w2, gla_gate_b, gla_norm_g, w_out, ln1_g, ln1_b,
              ca_wq, ca_wkv, ca_wo, ln2_g, ln2_b, ffn_w_in, ffn_conv_w, ffn_conv_b, ffn_w_out,
              ln3_g, ln3_b):
    B, S, D = x.shape
    M = mem.shape[1]
    inv_freq = ROPE_THETA ** (-jnp.arange(0, ROPE_DIMS, 2, dtype=jnp.float32) / ROPE_DIMS)
    ang = positions.astype(jnp.float32)[..., None] * inv_freq
    cos = jnp.cos(ang)[:, :, None, :]
    sin = jnp.sin(ang)[:, :, None, :]

    for l in range(DEPTH):
        h = x @ w_in[l]
        qg, kg, vg, rg, glr, qd, kd, vd = split_cols(h, IN_WIDTHS)
        log_g = jax.nn.log_sigmoid((glr @ gla_gate_w2[l] + gla_gate_b[l]).astype(jnp.float32)) / GLA_TAU
        o_g = gla_chunked(qg.reshape(B, S, GLA_HEADS, GLA_DK), kg.reshape(B, S, GLA_HEADS, GLA_DK),
                          vg.reshape(B, S, GLA_HEADS, GLA_DV), log_g.reshape(B, S, GLA_HEADS, GLA_DK))
        mu = jnp.mean(o_g, axis=-1, keepdims=True)
        var = jnp.mean(jnp.square(o_g - mu), axis=-1, keepdims=True)
        o_g = ((o_g - mu) * lax.rsqrt(var + LN_EPS)).reshape(B, S, GLA_HEADS * GLA_DV)
        o_g = (o_g * gla_norm_g[l].astype(jnp.float32) * jax.nn.silu(rg.astype(jnp.float32))).astype(x.dtype)
        qd = partial_rotary(qd.reshape(B, S, DIL_HEADS, DIL_HD) * (DIL_HD ** -0.5), cos, sin)
        kd = partial_rotary(kd.reshape(B, S, DIL_HEADS, DIL_HD), cos, sin)
        o_d = dilated_attention(qd, kd, vd.reshape(B, S, DIL_HEADS, DIL_HD))
        o_d = o_d.reshape(B, S, DIL_HEADS * DIL_HD).astype(x.dtype)
        mix = jnp.concatenate([o_g, o_d], axis=-1) @ w_out[l]
        x = layer_norm(DEEPNORM_ALPHA * x + mix, ln1_g[l], ln1_b[l])

        q = (x @ ca_wq[l]).reshape(B, S, CA_HEADS, CA_HD)
        mk, mv = split_cols(mem @ ca_wkv[l], (D_MODEL, D_MODEL))
        mk = mk.reshape(B, M, CA_HEADS, CA_HD)
        mv = mv.reshape(B, M, CA_HEADS, CA_HD)
        s = jnp.einsum('bshc,bmhc->bhsm', q, mk).astype(jnp.float32) * (CA_HD ** -0.5)
        p = jax.nn.softmax(s, axis=-1).astype(mv.dtype)
        o_c = jnp.einsum('bhsm,bmhc->bshc', p, mv).reshape(B, S, D_MODEL)
        x = layer_norm(DEEPNORM_ALPHA * x + o_c @ ca_wo[l], ln2_g[l], ln2_b[l])

        u = causal_dwconv(x @ ffn_w_in[l], ffn_conv_w[l], ffn_conv_b[l])
        gate, up = split_cols(u, (D_FF, D_FF))
        f = (jax.nn.silu(gate) * up) @ ffn_w_out[l]
        x = layer_norm(DEEPNORM_ALPHA * x + f, ln3_g[l], ln3_b[l])
    return x
```

```cpp
#include <hip/hip_runtime.h>
#include <hip/hip_cooperative_groups.h>
#include <cstdio>
namespace cg = cooperative_groups;

#ifndef ONE_LAUNCH
#define ONE_LAUNCH 1
#endif

#define LAS __attribute__((address_space(3)))
typedef unsigned short bf16_t;
typedef short bf16x8 __attribute__((ext_vector_type(8)));
typedef short s16x4 __attribute__((ext_vector_type(4)));
typedef float f32x4 __attribute__((ext_vector_type(4)));
typedef unsigned u32x4 __attribute__((ext_vector_type(4)));
typedef unsigned u32x2 __attribute__((ext_vector_type(2)));

constexpr int T_TOK = 16384, DM = 2048, SEQ = 4096, HC = 6144, DFF = 5504;
constexpr size_t MiB = 1ull << 20;
constexpr size_t OFF_B1 = 0;
constexpr size_t OFF_B2 = 64 * MiB;
constexpr size_t OFF_WIN = 128 * MiB, OFF_WOUT = 152 * MiB, OFF_WQ = 160 * MiB, OFF_WKV = 168 * MiB, OFF_WO = 184 * MiB;
constexpr size_t OFF_MEMB = 192 * MiB, OFF_MKV = 196 * MiB;
constexpr size_t OFF_LSE = 204 * MiB;
constexpr size_t OFF_CTR = 206 * MiB;
constexpr size_t OFF_ROPE = 206 * MiB + 4096;
constexpr size_t OFF_H = 209 * MiB;
constexpr size_t OFF_OC = 209 * MiB;
constexpr size_t OFF_MIX4 = 209 * MiB, OFF_MIX8 = 273 * MiB, OFF_MIX12 = 129 * MiB;
constexpr size_t OFF_X1B = 401 * MiB;
constexpr size_t OFF_OG = 401 * MiB;
constexpr size_t OFF_OD2 = 433 * MiB;
constexpr size_t OFF_EB = 465 * MiB, OFF_ENB = 481 * MiB;
constexpr size_t OFF_WF1 = 64 * MiB, OFF_WF2 = 107 * MiB;
constexpr size_t OFF_U = 129 * MiB;
constexpr size_t OFF_G = 301 * MiB;
constexpr size_t OFF_BAR = 500 * MiB;
constexpr size_t WS_NEED = 501 * MiB;

constexpr int LDS_BYTES = 143360;
constexpr int LDS_SLOT = 139264;
constexpr int KV_STRIDE = 272, KV_BUF = 256 * 272;

struct Params {
    const float* x; const float* mem; const int* pos; const float* w_in; const float* gate_w2; const float* gate_b; const float* norm_g;
    const float* w_out; const float* ln1_g; const float* ln1_b; const float* ca_wq; const float* ca_wkv; const float* ca_wo; const float* ln2_g; const float* ln2_b;
    const float* ffn_w_in; const float* conv_w; const float* conv_b; const float* ffn_w_out; const float* ln3_g; const float* ln3_b;
    float* out; unsigned char* ws; int ph_lo, ph_hi;
};

__constant__ float c_invf[16] = {1.000000000e+00f, 4.403665960e-01f, 1.939227432e-01f, 8.539710194e-02f, 3.760603070e-02f, 1.656043902e-02f, 7.292664610e-03f, 3.211445874e-03f,
                                 1.414213562e-03f, 6.227723788e-04f, 2.742481884e-04f, 1.207697351e-04f, 5.318296098e-05f, 2.341999971e-05f, 1.031338616e-05f, 4.541670478e-06f};

typedef float f32x2v __attribute__((ext_vector_type(2)));
typedef __bf16 b16x2v __attribute__((ext_vector_type(2)));
__device__ __forceinline__ unsigned cvt_pk_bf16(float lo, float hi) { const f32x2v v = {lo, hi}; const b16x2v r = __builtin_convertvector(v, b16x2v); return __builtin_bit_cast(unsigned, r); }
__device__ __forceinline__ float bflo(unsigned u) { return __uint_as_float(u << 16); }
__device__ __forceinline__ float bfhi(unsigned u) { return __uint_as_float(u & 0xffff0000u); }
__device__ __forceinline__ float fexp2(float x) { return __builtin_amdgcn_exp2f(x); }
__device__ __forceinline__ float flog2(float x) { return __builtin_amdgcn_logf(x); }
constexpr float LOG2E = 1.4426950408889634f, LN2 = 0.6931471805599453f;
__device__ __forceinline__ float silu_f(float v) { return v / (1.0f + fexp2(-v * LOG2E)); }

__device__ __forceinline__ int opaque_tid() { int t = (int)threadIdx.x; asm volatile("" : "+v"(t)); return t; }
__device__ __forceinline__ f32x4 mfma16(bf16x8 a, bf16x8 b, f32x4 c) { return __builtin_amdgcn_mfma_f32_16x16x32_bf16(a, b, c, 0, 0, 0); }

__device__ __forceinline__ bf16x8 frag_row(const LAS unsigned char* base, int stride, int row0, int k0, int idx, int g) {
    return *(const LAS bf16x8*)(base + (row0 + idx) * stride + (k0 + 8 * g) * 2);
}
__device__ __forceinline__ bf16x8 frag_tr(unsigned base_addr, int stride, int k0, int col0, int idx, int g) {
    const unsigned a0 = base_addr + (unsigned)((k0 + 8 * g + (idx >> 2)) * stride + (col0 + 4 * (idx & 3)) * 2);
    const unsigned a1 = a0 + 4u * (unsigned)stride;
    s16x4 r0, r1;
    asm volatile("ds_read_b64_tr_b16 %0, %2\n\tds_read_b64_tr_b16 %1, %3\n\ts_waitcnt lgkmcnt(0)" : "=&v"(r0), "=&v"(r1) : "v"(a0), "v"(a1) : "memory");
    bf16x8 f; f[0] = r0[0]; f[1] = r0[1]; f[2] = r0[2]; f[3] = r0[3]; f[4] = r1[0]; f[5] = r1[1]; f[6] = r1[2]; f[7] = r1[3]; return f;
}
__device__ __forceinline__ void tr_frag4(unsigned a, unsigned b, bf16x8 (&f)[4]) {
    s16x4 x0, x1, x2, x3, y0, y1, y2, y3;
    asm volatile("ds_read_b64_tr_b16 %0, %8\n\tds_read_b64_tr_b16 %1, %8 offset:32\n\tds_read_b64_tr_b16 %2, %8 offset:64\n\tds_read_b64_tr_b16 %3, %8 offset:96\n\t"
                 "ds_read_b64_tr_b16 %4, %9\n\tds_read_b64_tr_b16 %5, %9 offset:32\n\tds_read_b64_tr_b16 %6, %9 offset:64\n\tds_read_b64_tr_b16 %7, %9 offset:96\n\t"
                 "s_waitcnt lgkmcnt(0)"
                 : "=&v"(x0), "=&v"(x1), "=&v"(x2), "=&v"(x3), "=&v"(y0), "=&v"(y1), "=&v"(y2), "=&v"(y3) : "v"(a), "v"(b) : "memory");
#define MK(F, X, Y) F[0] = X[0]; F[1] = X[1]; F[2] = X[2]; F[3] = X[3]; F[4] = Y[0]; F[5] = Y[1]; F[6] = Y[2]; F[7] = Y[3];
    MK(f[0], x0, y0) MK(f[1], x1, y1) MK(f[2], x2, y2) MK(f[3], x3, y3)
#undef MK
}

constexpr int BM = 256, BK = 64, HALF = 128, HTB = HALF * BK * 2, NXCD = 8, WGM = 8;
__device__ __forceinline__ int lds_byte(int r, int c) { const int st = (r >> 4) * 2 + (c >> 5), rr = r & 15, cc = c & 31, ob = rr * 64 + cc * 2; return st * 1024 + (ob ^ (((ob >> 9) & 1) << 5)); }
__device__ __forceinline__ void stage_rc(int b, int& R, int& C) { const int st = b / 1024, sb = b % 1024, swz = sb ^ (((sb >> 9) & 1) << 5); R = (st >> 1) * 16 + swz / 64; C = (st & 1) * 32 + (swz % 64) / 2; }
__device__ __forceinline__ int perm32(int rho) { const int n = rho >> 4, i = rho & 15; return 8 * (i >> 2) + 4 * n + (i & 3); }

struct GemmDesc {
    const bf16_t* A; const bf16_t* Bt; void* C; const float* R; const float* rope; float* aux;
    int M, N, K, ldc, mode, G, c, rbf;
};
struct Unit { int pm, pn; };
__device__ __forceinline__ bool unit_next(const GemmDesc& d, int i, Unit& u) {
    const int nM = d.M / BM, nN = d.N / BM, nwg = nM * nN;
    const long L = (long)i * d.G + d.c; if (L >= nwg) return false;
    int wgid = (int)L; { const int q = nwg / NXCD, r = nwg % NXCD, xcd = wgid % NXCD, off = wgid / NXCD; wgid = (xcd < r ? xcd * (q + 1) : r * (q + 1) + (xcd - r) * q) + off; }
    const int nig = WGM * nN, gid = wgid / nig, fm = gid * WGM, gsz = (nM - fm) < WGM ? (nM - fm) : WGM;
    u.pm = fm + ((wgid % nig) % gsz); u.pn = (wgid % nig) / gsz; return true;
}
constexpr float DN_ALPHA = 1.189207115002721f;

__device__ __forceinline__ void gemm_epilogue(const GemmDesc& d, const f32x4 (&acc)[2][2][4][2], const Unit& u, int wr, int wc, int fr, int fq) {
    if (d.mode == 2) {
        const int row0 = u.pm * BM + wr * 64 + fr, col0 = u.pn * BM + wc * 32 + 4 * fq;
        float* C = (float*)d.C; const float* R = d.R;
#pragma unroll
        for (int ai = 0; ai < 2; ++ai)
#pragma unroll
            for (int m = 0; m < 4; ++m) {
                const size_t ro = (size_t)(row0 + ai * HALF + m * 16) * d.ldc + col0;
#pragma unroll
                for (int bj = 0; bj < 2; ++bj)
#pragma unroll
                    for (int n = 0; n < 2; ++n) {
                        f32x4 r;
                        if (d.rbf) { const u32x2 rb = *(const u32x2*)((const bf16_t*)d.R + ro + bj * HALF + n * 16); r[0] = bflo(rb.x); r[1] = bfhi(rb.x); r[2] = bflo(rb.y); r[3] = bfhi(rb.y); }
                        else r = *(const f32x4*)(R + ro + bj * HALF + n * 16);
                        *(f32x4*)(C + ro + bj * HALF + n * 16) = r * DN_ALPHA + acc[ai][bj][m][n]; }
            }
    } else {
        const int row0 = u.pm * BM + wr * 64 + fr, col0 = u.pn * BM + wc * 32 + 8 * fq;
        bf16_t* O = (bf16_t*)d.C;
        const bool ropet = (d.mode == 1) && (u.pn >= 12) && (u.pn < 20) && (wc == 0);
        const float qs = (d.mode == 1 && (u.pn < 2 || (u.pn >= 12 && u.pn < 16))) ? 0.08838834764831845f : 1.0f;
        const bool gate = (d.mode == 1) && (u.pn < 4);
        const bf16_t* gtab = (const bf16_t*)d.aux + (u.pn & 1) * 256 + wc * 32 + 8 * fq;
        const bool ginv = (u.pn >= 2);
#pragma unroll
        for (int ai = 0; ai < 2; ++ai)
#pragma unroll
            for (int m = 0; m < 4; ++m) {
                const int row = row0 + ai * HALF + m * 16;
                bf16_t* rowp = O + (size_t)row * d.ldc + col0;
                f32x4 c0 = {1.f, 1.f, 1.f, 1.f}, c1 = c0, s0 = {0.f, 0.f, 0.f, 0.f}, s1 = s0;
                if (ropet) { const float* tp = d.rope + (size_t)row * 32 + 8 * (fq & 1); c0 = *(const f32x4*)tp; c1 = *(const f32x4*)(tp + 4); s0 = *(const f32x4*)(tp + 16); s1 = *(const f32x4*)(tp + 20);
                    if (fq < 2) { s0 = -s0; s1 = -s1; } }
#pragma unroll
                for (int bj = 0; bj < 2; ++bj) {
                    f32x4 v0 = acc[ai][bj][m][0] * qs, v1 = acc[ai][bj][m][1] * qs;
                    if (gate) { const u32x4 e = *(const u32x4*)(gtab + (size_t)row * 512 + bj * HALF);
                        float f[8] = {bflo(e.x), bfhi(e.x), bflo(e.y), bfhi(e.y), bflo(e.z), bfhi(e.z), bflo(e.w), bfhi(e.w)};
                        if (ginv) {
#pragma unroll
                            for (int j = 0; j < 8; ++j) f[j] = __builtin_amdgcn_rcpf(f[j]); }
                        v0[0] *= f[0]; v0[1] *= f[1]; v0[2] *= f[2]; v0[3] *= f[3]; v1[0] *= f[4]; v1[1] *= f[5]; v1[2] *= f[6]; v1[3] *= f[7]; }
                    if (ropet) {
                        f32x4 p0, p1;
#pragma unroll
                        for (int j = 0; j < 4; ++j) { p0[j] = __shfl_xor(v0[j], 32); p1[j] = __shfl_xor(v1[j], 32); }
                        v0 = v0 * c0 + p0 * s0; v1 = v1 * c1 + p1 * s1;
                    }
                    u32x4 w; w.x = cvt_pk_bf16(v0[0], v0[1]); w.y = cvt_pk_bf16(v0[2], v0[3]); w.z = cvt_pk_bf16(v1[0], v1[1]); w.w = cvt_pk_bf16(v1[2], v1[3]);
                    *(u32x4*)(rowp + bj * HALF) = w;
                }
            }
    }
}


__device__ __forceinline__ f32x4 dpp_prev(f32x4 v) {
    f32x4 r;
#pragma unroll
    for (int j = 0; j < 4; ++j) { const float x = v[j]; r[j] = __int_as_float(__builtin_amdgcn_update_dpp(0, __float_as_int(x), 0x111, 0xF, 0xF, true)); }
    return r;
}
__device__ __forceinline__ void conv_epilogue(const GemmDesc& d, const f32x4 (&acc)[2][2][4][2], const Unit& u, int wr, int wc, int fr, int fq, LAS unsigned char* lds) {
    const int L = 16 * wr + fr;
    const bool seq_start = (u.pm & 15) == 0;
    const int ch0 = u.pn * 128 + wc * 32 + fq * 8;
    if (fr == 0 || fr == 15) {
        const int rbase = (fr == 0) ? 4 * wr : 4 * wr + 2;
#pragma unroll
        for (int e2 = 0; e2 < 2; ++e2)
#pragma unroll
            for (int bj = 0; bj < 2; ++bj)
#pragma unroll
                for (int n = 0; n < 2; ++n) {
                    const f32x4 v = (fr == 0) ? acc[0][bj][e2][n] : acc[1][bj][2 + e2][n];
                    *(f32x4*)(d.aux + ((size_t)((u.pm * 8 + rbase + e2) * 2 + bj)) * DFF + ch0 + 4 * n) = v;
                }
    }
    bf16_t* gout = (bf16_t*)d.C;
#pragma unroll
    for (int n = 0; n < 2; ++n) {
        const int ch = ch0 + 4 * n;
        const f32x4 wg0 = *(const f32x4*)(d.R + ch), wg1 = *(const f32x4*)(d.R + 11008 + ch), wg2 = *(const f32x4*)(d.R + 22016 + ch);
        const f32x4 wu0 = *(const f32x4*)(d.R + DFF + ch), wu1 = *(const f32x4*)(d.R + 11008 + DFF + ch), wu2 = *(const f32x4*)(d.R + 22016 + DFF + ch);
        const f32x4 bg = *(const f32x4*)(d.rope + ch), bu = *(const f32x4*)(d.rope + DFF + ch);
        f32x4 pg2 = dpp_prev(acc[1][0][2][n]), pg1 = dpp_prev(acc[1][0][3][n]), pu2 = dpp_prev(acc[1][1][2][n]), pu1 = dpp_prev(acc[1][1][3][n]);
        if (fr == 0) { pg2 = (f32x4){0.f, 0.f, 0.f, 0.f}; pg1 = pg2; pu2 = pg2; pu1 = pg2; }
#pragma unroll
        for (int e = 0; e < 8; ++e) {
            const f32x4 cg_ = acc[e >> 2][0][e & 3][n], cu_ = acc[e >> 2][1][e & 3][n];
            const f32x4 yg = bg + wg0 * pg2 + wg1 * pg1 + wg2 * cg_;
            const f32x4 yu = bu + wu0 * pu2 + wu1 * pu1 + wu2 * cu_;
            f32x4 r;
#pragma unroll
            for (int j = 0; j < 4; ++j) r[j] = silu_f(yg[j]) * yu[j];
            u32x2 pk; pk.x = cvt_pk_bf16(r[0], r[1]); pk.y = cvt_pk_bf16(r[2], r[3]);
            { const bool skip = (fr == 0) && (e < 2) && !(wr == 0 && seq_start);
              if (!skip) *(u32x2*)(gout + (size_t)(u.pm * 256 + 8 * L + e) * DFF + ch) = pk; }
            pg2 = pg1; pg1 = cg_; pu2 = pu1; pu1 = cu_;
        }
    }
}

__device__ __forceinline__ void gemm_phase(LAS unsigned char* lds, const GemmDesc& g) {
    const int tid = opaque_tid(), wid = __builtin_amdgcn_readfirstlane(tid >> 6), lane = tid & 63, wr = wid >> 2, wc = wid & 3, fr = lane & 15, fq = lane >> 4;
    const int K = g.K, nt = K / BK;
    const bool perm = (g.mode != 2);
    unsigned voffA[2], voffB[2];
#pragma unroll
    for (int i = 0; i < 2; ++i) { int R, C; stage_rc(tid * 16 + i * 8192, R, C); const int Rb = perm ? ((R & ~31) + perm32(R & 31)) : R;
        const int Ra = (g.mode == 3) ? (8 * (16 * (R >> 6) + (R & 15)) + ((R >> 4) & 3)) : R;
        voffA[i] = (unsigned)(Ra * K + C) * 2u; voffB[i] = (unsigned)(Rb * K + C) * 2u; }
    const size_t kstep = (size_t)(BK * 2);
    const size_t hstep = (size_t)HALF * K * 2;
    const size_t tstep = 2 * hstep;
    const size_t hstepA = (g.mode == 3) ? (size_t)4 * K * 2 : hstep;
    const unsigned ldsw = (unsigned)wid * 1024u;
    const int aoff = lds_byte(wr * 64 + fr, fq * 8), boff = lds_byte(wc * 32 + fr, fq * 8);
#define PG8_SA(b, h) (((b) * 2 + (h)) * HTB)
#define PG8_SB(b, h) ((4 + (b) * 2 + (h)) * HTB)
#define PG8_STAGE(bufoff, gbase, voff) do { _Pragma("unroll") for (int _i = 0; _i < 2; ++_i) \
        __builtin_amdgcn_global_load_lds((const unsigned*)((const char*)(gbase) + (voff)[_i]), (LAS unsigned*)(lds + (bufoff) + ldsw + _i * 8192), 16, 0, 0); } while (0)
#define PG8_LDA(dst, b, h) do { _Pragma("unroll") for (int m = 0; m < 4; ++m) _Pragma("unroll") for (int k = 0; k < 2; ++k) dst[m][k] = *(const LAS bf16x8*)(lds + PG8_SA(b, h) + aoff + m * 2048 + k * 1024); } while (0)
#define PG8_LDB(dst, b, h) do { _Pragma("unroll") for (int n = 0; n < 2; ++n) _Pragma("unroll") for (int k = 0; k < 2; ++k) dst[n][k] = *(const LAS bf16x8*)(lds + PG8_SB(b, h) + boff + n * 2048 + k * 1024); } while (0)
#define PG8_MMA(ai, bj, At, Bt) do { __builtin_amdgcn_s_setprio(1); _Pragma("unroll") for (int m = 0; m < 4; ++m) _Pragma("unroll") for (int n = 0; n < 2; ++n) _Pragma("unroll") for (int k = 0; k < 2; ++k) \
        acc[ai][bj][m][n] = __builtin_amdgcn_mfma_f32_16x16x32_bf16(Bt[n][k], At[m][k], acc[ai][bj][m][n], 0, 0, 0); __builtin_amdgcn_s_setprio(0); } while (0)
#define PG8_WAIT_V(n) asm volatile("s_waitcnt vmcnt(" #n ")" ::: "memory")
#define PG8_WAIT_L(n) asm volatile("s_waitcnt lgkmcnt(" #n ")" ::: "memory")
#define PG8_BAR __builtin_amdgcn_s_barrier()
#define PG8_SCHED __builtin_amdgcn_sched_barrier(0)
    Unit cur, nxt; int ui = 0;
    if (!unit_next(g, 0, cur)) return;
    f32x4 acc[2][2][4][2];
#pragma unroll
    for (int a = 0; a < 2; ++a)
#pragma unroll
        for (int b = 0; b < 2; ++b)
#pragma unroll
            for (int m = 0; m < 4; ++m)
#pragma unroll
                for (int n = 0; n < 2; ++n) acc[a][b][m][n] = (f32x4){0.f, 0.f, 0.f, 0.f};
    bf16x8 At[4][2], B0[2][2], B1[2][2];
    const char* cA = (const char*)g.A + (size_t)cur.pm * tstep; const char* cB = (const char*)g.Bt + (size_t)cur.pn * tstep;
    PG8_STAGE(PG8_SB(0, 0), cB, voffB); PG8_STAGE(PG8_SA(0, 0), cA, voffA); PG8_STAGE(PG8_SB(0, 1), cB + hstep, voffB); PG8_STAGE(PG8_SA(0, 1), cA + hstepA, voffA);
    if (wr == 1) PG8_BAR;
    PG8_WAIT_V(4); PG8_BAR;
    PG8_STAGE(PG8_SB(1, 0), cB + kstep, voffB); PG8_STAGE(PG8_SA(1, 0), cA + kstep, voffA); PG8_STAGE(PG8_SB(1, 1), cB + hstep + kstep, voffB);
    PG8_WAIT_V(6); PG8_BAR;
    for (;;) {
        const bool has_next = unit_next(g, ui + 1, nxt);
        const char* nA = has_next ? (const char*)g.A + (size_t)nxt.pm * tstep : cA; const char* nB = has_next ? (const char*)g.Bt + (size_t)nxt.pn * tstep : cB;
        for (int t = 0; t < nt; t += 2) {
            const bool last = (t == nt - 2);
            const char* a1 = cA + (size_t)(t + 1) * kstep;
            const char* a2 = last ? nA : cA + (size_t)(t + 2) * kstep; const char* b2 = last ? nB : cB + (size_t)(t + 2) * kstep;
            const char* a3 = a2 + kstep; const char* b3 = b2 + kstep;
            PG8_LDB(B0, 0, 0); PG8_SCHED; PG8_LDA(At, 0, 0); PG8_STAGE(PG8_SA(1, 1), a1 + hstepA, voffA);
            PG8_WAIT_L(8); PG8_BAR; PG8_WAIT_L(0); PG8_MMA(0, 0, At, B0); PG8_BAR; PG8_SCHED;
            PG8_LDB(B1, 0, 1); PG8_STAGE(PG8_SB(0, 0), b2, voffB);
            PG8_BAR; PG8_WAIT_L(0); PG8_MMA(0, 1, At, B1); PG8_BAR;
            PG8_LDA(At, 0, 1); PG8_STAGE(PG8_SA(0, 0), a2, voffA);
            PG8_BAR; PG8_WAIT_L(0); PG8_MMA(1, 0, At, B0); PG8_BAR; PG8_SCHED;
            PG8_STAGE(PG8_SB(0, 1), b2 + hstep, voffB);
            PG8_WAIT_V(6); PG8_BAR; PG8_MMA(1, 1, At, B1); PG8_BAR;
            PG8_LDB(B0, 1, 0); PG8_SCHED; PG8_LDA(At, 1, 0); PG8_STAGE(PG8_SA(0, 1), a2 + hstepA, voffA);
            PG8_WAIT_L(8); PG8_BAR; PG8_WAIT_L(0); PG8_MMA(0, 0, At, B0); PG8_BAR; PG8_SCHED;
            PG8_LDB(B1, 1, 1); PG8_STAGE(PG8_SB(1, 0), b3, voffB);
            PG8_BAR; PG8_WAIT_L(0); PG8_MMA(0, 1, At, B1); PG8_BAR;
            PG8_LDA(At, 1, 1); PG8_STAGE(PG8_SA(1, 0), a3, voffA);
            PG8_BAR; PG8_WAIT_L(0); PG8_MMA(1, 0, At, B0); PG8_BAR; PG8_SCHED;
            PG8_STAGE(PG8_SB(1, 1), b3 + hstep, voffB);
            PG8_WAIT_V(6); PG8_BAR; PG8_MMA(1, 1, At, B1); PG8_BAR;
        }
        if (g.mode == 3) conv_epilogue(g, acc, cur, wr, wc, fr, fq, lds); else gemm_epilogue(g, acc, cur, wr, wc, fr, fq);
        if (!has_next) break;
#pragma unroll
        for (int a = 0; a < 2; ++a)
#pragma unroll
            for (int b = 0; b < 2; ++b)
#pragma unroll
                for (int m = 0; m < 4; ++m)
#pragma unroll
                    for (int n = 0; n < 2; ++n) acc[a][b][m][n] = (f32x4){0.f, 0.f, 0.f, 0.f};
        cur = nxt; cA = nA; cB = nB; ++ui;
    }
    PG8_WAIT_V(0);
    if (wr == 0) PG8_BAR;
    PG8_BAR;
#undef PG8_SA
#undef PG8_SB
#undef PG8_STAGE
#undef PG8_LDA
#undef PG8_LDB
#undef PG8_MMA
#undef PG8_WAIT_V
#undef PG8_WAIT_L
#undef PG8_BAR
#undef PG8_SCHED
}

__device__ __forceinline__ void wt_tile(const float* __restrict__ W, int ldw, int k0, int n0src, bf16_t* __restrict__ Bt, int K, int n0dst, float* tile) {
    const int tid = opaque_tid();
    { const int r = tid >> 4, c4 = tid & 15;
#pragma unroll
      for (int i = 0; i < 2; ++i) { const f32x4 v = *(const f32x4*)(W + (size_t)(k0 + r + 32 * i) * ldw + n0src + 4 * c4); float* tp = tile + (r + 32 * i) * 65 + 4 * c4; tp[0] = v[0]; tp[1] = v[1]; tp[2] = v[2]; tp[3] = v[3]; } }
    __syncthreads();
    { const int n = tid >> 3, kg = tid & 7; float v[8];
#pragma unroll
      for (int e = 0; e < 8; ++e) v[e] = tile[(8 * kg + e) * 65 + n];
      u32x4 w; w.x = cvt_pk_bf16(v[0], v[1]); w.y = cvt_pk_bf16(v[2], v[3]); w.z = cvt_pk_bf16(v[4], v[5]); w.w = cvt_pk_bf16(v[6], v[7]);
      *(u32x4*)(Bt + (size_t)(n0dst + n) * K + k0 + 8 * kg) = w; }
    __syncthreads();
}


struct WtDesc { const float* W; bf16_t* Bt; int ldw, k0, ns0, ns1, K, n0dst; };
__device__ __forceinline__ WtDesc wt_decode(const Params& p, int grp, int tl) {
    WtDesc d; unsigned char* ws = p.ws;
    if (grp == 0) {
        if (tl < 768)       { const int kt = tl & 31, nt = tl >> 5; const int n0 = nt * 256, s0 = n0 + (n0 >= 3072 ? 16 : 0); d.W = p.w_in; d.ldw = 6160; d.k0 = kt * 64; d.ns0 = s0; d.ns1 = s0 + 128; d.Bt = (bf16_t*)(ws + OFF_WIN); d.K = 2048; d.n0dst = n0; }
        else if (tl < 1024) { const int q = tl - 768;  d.W = p.w_out;  d.ldw = 2048; d.k0 = (q & 31) * 64; d.ns0 = (q >> 5) * 256; d.ns1 = d.ns0 + 128; d.Bt = (bf16_t*)(ws + OFF_WOUT); d.K = 2048; d.n0dst = d.ns0; }
        else if (tl < 1280) { const int q = tl - 1024; d.W = p.ca_wq;  d.ldw = 2048; d.k0 = (q & 31) * 64; d.ns0 = (q >> 5) * 256; d.ns1 = d.ns0 + 128; d.Bt = (bf16_t*)(ws + OFF_WQ);   d.K = 2048; d.n0dst = d.ns0; }
        else if (tl < 1792) { const int q = tl - 1280; d.W = p.ca_wkv; d.ldw = 4096; d.k0 = (q & 31) * 64; d.ns0 = (q >> 5) * 256; d.ns1 = d.ns0 + 128; d.Bt = (bf16_t*)(ws + OFF_WKV);  d.K = 2048; d.n0dst = d.ns0; }
        else                { const int q = tl - 1792; d.W = p.ca_wo;  d.ldw = 2048; d.k0 = (q & 31) * 64; d.ns0 = (q >> 5) * 256; d.ns1 = d.ns0 + 128; d.Bt = (bf16_t*)(ws + OFF_WO);   d.K = 2048; d.n0dst = d.ns0; }
    } else {
        if (tl < 1376) { const int kt = tl & 31, pn = tl >> 5; d.W = p.ffn_w_in; d.ldw = 11008; d.k0 = kt * 64; d.ns0 = pn * 128; d.ns1 = DFF + pn * 128; d.Bt = (bf16_t*)(ws + OFF_WF1); d.K = 2048; d.n0dst = pn * 256; }
        else { const int q = tl - 1376; const int kt = q % 86, nt = q / 86; d.W = p.ffn_w_out; d.ldw = 2048; d.k0 = kt * 64; d.ns0 = nt * 256; d.ns1 = d.ns0 + 128; d.Bt = (bf16_t*)(ws + OFF_WF2); d.K = DFF; d.n0dst = nt * 256; }
    }
    return d;
}
__device__ __forceinline__ void wt_load(const WtDesc& d, int tid, f32x4 (&v)[8]) {
    const int r = tid >> 6, c4 = tid & 63; const int col = (c4 < 32) ? d.ns0 + 4 * c4 : d.ns1 + 4 * (c4 - 32);
#pragma unroll
    for (int i = 0; i < 8; ++i) v[i] = *(const f32x4*)(d.W + (size_t)(d.k0 + r + 8 * i) * d.ldw + col);
}
__device__ __forceinline__ int wt_remap(int grp, int t) { return (grp == 2) ? (t < 768 ? t : t + 512) : t; }
__device__ void wt_run(const Params& p, int grp, int first, int stride, int ntiles, unsigned char* smem_g) {
    constexpr int LD = 260;
    float* tile = (float*)smem_g;
    const int tid = opaque_tid();
    int tl = first;
    if (tl >= ntiles) return;
    const int dg = (grp == 2) ? 0 : grp;
    WtDesc cur = wt_decode(p, dg, wt_remap(grp, tl)); f32x4 v[8];
    wt_load(cur, tid, v);
    for (;;) {
        { const int r = tid >> 6, c4 = tid & 63;
#pragma unroll
          for (int i = 0; i < 8; ++i) *(f32x4*)(tile + (r + 8 * i) * LD + 4 * c4) = v[i]; }
        const int nxt = tl + stride; const bool has = nxt < ntiles;
        WtDesc nd = cur;
        if (has) { nd = wt_decode(p, dg, wt_remap(grp, nxt)); wt_load(nd, tid, v); }
        __syncthreads();
        { const int n = tid >> 1, kh = tid & 1;
#pragma unroll
          for (int q = 0; q < 4; ++q) {
              float e[8];
#pragma unroll
              for (int j = 0; j < 8; ++j) e[j] = tile[(32 * kh + 8 * q + j) * LD + n];
              u32x4 w; w.x = cvt_pk_bf16(e[0], e[1]); w.y = cvt_pk_bf16(e[2], e[3]); w.z = cvt_pk_bf16(e[4], e[5]); w.w = cvt_pk_bf16(e[6], e[7]);
              *(u32x4*)(cur.Bt + (size_t)(cur.n0dst + n) * cur.K + cur.k0 + 32 * kh + 8 * q) = w;
          } }
        __syncthreads();
        if (!has) break;
        tl = nxt; cur = nd;
    }
}


__device__ void wt_one(const Params& p, int grp, int tl, unsigned char* smem_g) {
    constexpr int LD = 260;
    float* tile = (float*)smem_g;
    const int tid = opaque_tid();
    const WtDesc cur = wt_decode(p, grp, tl); f32x4 v[8];
    wt_load(cur, tid, v);
    { const int r = tid >> 6, c4 = tid & 63;
#pragma unroll
      for (int i = 0; i < 8; ++i) *(f32x4*)(tile + (r + 8 * i) * LD + 4 * c4) = v[i]; }
    __syncthreads();
    { const int n = tid >> 1, kh = tid & 1;
#pragma unroll
      for (int q = 0; q < 4; ++q) {
          float e[8];
#pragma unroll
          for (int j = 0; j < 8; ++j) e[j] = tile[(32 * kh + 8 * q + j) * LD + n];
          u32x4 w; w.x = cvt_pk_bf16(e[0], e[1]); w.y = cvt_pk_bf16(e[2], e[3]); w.z = cvt_pk_bf16(e[4], e[5]); w.w = cvt_pk_bf16(e[6], e[7]);
          *(u32x4*)(cur.Bt + (size_t)(cur.n0dst + n) * cur.K + cur.k0 + 32 * kh + 8 * q) = w;
      } }
    __syncthreads();
}

__device__ void prep_phase(const Params& p, unsigned char* smem_g) {
    const int tid = opaque_tid(), lane = tid & 63, wid = tid >> 6, idx = lane & 15, g = lane >> 4;
    unsigned char* ws = p.ws;
    float* red = (float*)smem_g;
    float* glrs = (float*)(smem_g + 32768);
    if (blockIdx.x == 0 && tid < 64) ((unsigned*)(ws + OFF_CTR))[tid] = 0u;
    bf16_t* xb = (bf16_t*)(ws + OFF_B1);
    bf16_t* ebp = (bf16_t*)(ws + OFF_EB); bf16_t* enbp = (bf16_t*)(ws + OFF_ENB);
    for (int ch = blockIdx.x; ch < T_TOK / 64; ch += gridDim.x) {
        const int t0 = ch * 64;
        const int wk = (wid + (int)blockIdx.x) & 7, mrot = ((int)blockIdx.x >> 3) & 3;
        bf16x8 bfr[8];
#pragma unroll
        for (int ks = 0; ks < 8; ++ks) {
            float v[8];
#pragma unroll
            for (int e = 0; e < 8; ++e) v[e] = p.w_in[(size_t)(256 * wk + 32 * ks + 8 * g + e) * 6160 + 3072 + idx];
            u32x4 w; w.x = cvt_pk_bf16(v[0], v[1]); w.y = cvt_pk_bf16(v[2], v[3]); w.z = cvt_pk_bf16(v[4], v[5]); w.w = cvt_pk_bf16(v[6], v[7]);
            bfr[ks] = __builtin_bit_cast(bf16x8, w);
        }
        f32x4 acc[4];
#pragma unroll
        for (int mt = 0; mt < 4; ++mt) {
            acc[mt] = (f32x4){0.f, 0.f, 0.f, 0.f};
#pragma unroll
            for (int ks = 0; ks < 8; ++ks) {
                const size_t off = (size_t)(t0 + 16 * ((mt + mrot) & 3) + idx) * DM + 256 * wk + 32 * ks + 8 * g;
                const f32x4 a = *(const f32x4*)(p.x + off), b = *(const f32x4*)(p.x + off + 4);
                u32x4 w; w.x = cvt_pk_bf16(a[0], a[1]); w.y = cvt_pk_bf16(a[2], a[3]); w.z = cvt_pk_bf16(b[0], b[1]); w.w = cvt_pk_bf16(b[2], b[3]);
                *(u32x4*)(xb + off) = w;
                acc[mt] = mfma16(__builtin_bit_cast(bf16x8, w), bfr[ks], acc[mt]);
            }
        }
#pragma unroll
        for (int mt = 0; mt < 4; ++mt)
#pragma unroll
            for (int r = 0; r < 4; ++r) red[(wid * 64 + 16 * ((mt + mrot) & 3) + 4 * g + r) * 16 + idx] = acc[mt][r];
        __syncthreads();
        { const int tok = tid >> 3, c2 = (tid & 7) * 2; float s0 = 0.f, s1 = 0.f;
#pragma unroll
          for (int w = 0; w < 8; ++w) { s0 += red[(w * 64 + tok) * 16 + c2]; s1 += red[(w * 64 + tok) * 16 + c2 + 1]; }
          glrs[tok * 16 + c2] = s0; glrs[tok * 16 + c2 + 1] = s1; }
        __syncthreads();
        { const int c = tid; float w2c[16];
#pragma unroll
          for (int r = 0; r < 16; ++r) w2c[r] = p.gate_w2[r * 512 + c];
          const float bias = p.gate_b[c]; float b2 = 0.f;
          for (int t = 0; t < 64; ++t) {
              float z = bias;
#pragma unroll
              for (int r4 = 0; r4 < 4; ++r4) { const f32x4 gv = *(const f32x4*)(glrs + t * 16 + 4 * r4); z += gv[0] * w2c[4 * r4] + gv[1] * w2c[4 * r4 + 1] + gv[2] * w2c[4 * r4 + 2] + gv[3] * w2c[4 * r4 + 3]; }
              const float az = fabsf(z);
              const float ls2 = fminf(z, 0.f) * LOG2E - flog2(1.0f + fexp2(-az * LOG2E));
              b2 += ls2 * 0.0625f;
              const float e = fexp2(b2);
              ebp[(size_t)(t0 + t) * 512 + c] = (bf16_t)(cvt_pk_bf16(e, e) & 0xffffu);
          } }
        __syncthreads();
    }
    { float* tab = (float*)(ws + OFF_ROPE);
      for (int e = blockIdx.x * 512 + tid; e < T_TOK * 16; e += gridDim.x * 512) {
          const int tok = e >> 4, i = e & 15;
          const float ang = (float)p.pos[tok] * c_invf[i];
          const double rev = (double)ang * 0.15915494309189535; const float fr = (float)(rev - rint(rev));
          tab[tok * 32 + i] = __builtin_amdgcn_cosf(fr); tab[tok * 32 + 16 + i] = __builtin_amdgcn_sinf(fr);
      } }
    { bf16_t* mb = (bf16_t*)(ws + OFF_MEMB);
      for (int e = blockIdx.x * 512 + tid; e < 1024 * 2048 / 4; e += gridDim.x * 512) { const f32x4 v = *(const f32x4*)(p.mem + (size_t)e * 4); u32x2 w; w.x = cvt_pk_bf16(v[0], v[1]); w.y = cvt_pk_bf16(v[2], v[3]); *(u32x2*)(mb + (size_t)e * 4) = w; } }
    wt_run(p, 2, (int)blockIdx.x, (int)gridDim.x, 1280, smem_g);
}

__device__ void ffn_weights(const Params& p, unsigned char* smem_g) { wt_run(p, 1, (int)blockIdx.x, (int)gridDim.x, 1376, smem_g); }

struct GlaRegs { u32x4 rq[2], rk[2], rv; u32x2 rdec; };
#define GLD(dst, ptr) asm volatile("global_load_dwordx4 %0, %1, off" : "=v"(dst) : "v"(ptr) : "memory")
#define GLD2(dst, ptr) asm volatile("global_load_dwordx2 %0, %1, off" : "=v"(dst) : "v"(ptr) : "memory")
__device__ __forceinline__ void gla_load(GlaRegs& R, int n, int t, const bf16_t* hq, const bf16_t* hv, const bf16_t* pdec) {
    const size_t tk = (size_t)(n * 64 + t);
    const bf16_t* a0 = hq + tk * HC; const bf16_t* a3 = pdec + (size_t)(n * 64 + 63) * 512; const bf16_t* a4 = hv + tk * HC;
    GLD(R.rq[0], a0); GLD(R.rq[1], a0 + 8); GLD(R.rk[0], a0 + 512); GLD(R.rk[1], a0 + 520); GLD(R.rv, a4); GLD2(R.rdec, a3);
}
__device__ __forceinline__ void gla_wait(GlaRegs& R, bool first) {
    if (first) asm volatile("s_waitcnt vmcnt(6)" : "+v"(R.rq[0]), "+v"(R.rq[1]), "+v"(R.rk[0]), "+v"(R.rk[1]), "+v"(R.rv), "+v"(R.rdec) :: "memory");
    else       asm volatile("s_waitcnt vmcnt(10)" : "+v"(R.rq[0]), "+v"(R.rq[1]), "+v"(R.rk[0]), "+v"(R.rk[1]), "+v"(R.rv), "+v"(R.rdec) :: "memory");
}
#define MKF(F, X, Y) F[0] = X[0]; F[1] = X[1]; F[2] = X[2]; F[3] = X[3]; F[4] = Y[0]; F[5] = Y[1]; F[6] = Y[2]; F[7] = Y[3];
#define LDS_BARRIER() do { asm volatile("s_waitcnt lgkmcnt(0)" ::: "memory"); __builtin_amdgcn_s_barrier(); asm volatile("" ::: "memory"); } while (0)
__device__ void gla_item(const Params& p, int item, LAS unsigned char* lds) {
    const int tid = opaque_tid(), lane = tid & 63, w = __builtin_amdgcn_readfirstlane(tid >> 6), idx = lane & 15, g = lane >> 4;
    const int b = item >> 4, hh = (item >> 2) & 3, sl = item & 3;
    constexpr int QS0 = 0, KS = 34816, VS0 = 52224, ST0 = 70656, AS = 105472;
    const unsigned lbase = (unsigned)(size_t)lds;
    unsigned char* ws = p.ws;
    const bf16_t* h = (const bf16_t*)(ws + OFF_H);
    bf16_t* og = (bf16_t*)(ws + OFF_OG);
    const int t = tid >> 3, cgp = tid & 7;
    const bf16_t* hq = h + (size_t)(b * SEQ) * HC + hh * 128 + cgp * 16;
    const bf16_t* hv = h + (size_t)(b * SEQ) * HC + 1024 + hh * 256 + sl * 64 + cgp * 8;
    const bf16_t* pdec = (const bf16_t*)(ws + OFF_EB) + (size_t)(b * SEQ) * 512 + hh * 128 + 16 * w + 4 * g;
    { unsigned zz = 0u; asm volatile("" : "+v"(zz)); const u32x4 zv = {zz, zz, zz, zz};
      for (int i = tid; i < 17408 / 16; i += 512) *(LAS u32x4*)(lds + ST0 + i * 16) = zv; }
    f32x4 S[4];
#pragma unroll
    for (int i = 0; i < 4; ++i) S[i] = (f32x4){0.f, 0.f, 0.f, 0.f};
    const int jt = w >> 1, it0 = 2 * (w & 1);
    GlaRegs RA, RB;
    gla_load(RA, 0, t, hq, hv, pdec); gla_load(RB, 1, t, hq, hv, pdec);
    for (int n2 = 0; n2 < 64; n2 += 2) {
#pragma unroll
      for (int par = 0; par < 2; ++par) {
        const int n = n2 + par;
        GlaRegs& R = par ? RB : RA;
        const int qs = QS0 + par * 17408, vs = VS0 + par * 9216, stc = ST0 + par * 17408, stn = ST0 + (par ^ 1) * 17408;
        gla_wait(R, n2 == 0);
        *(LAS u32x4*)(lds + qs + t * 272 + cgp * 32) = R.rq[0]; *(LAS u32x4*)(lds + qs + t * 272 + cgp * 32 + 16) = R.rq[1];
        *(LAS u32x4*)(lds + KS + t * 272 + cgp * 32) = R.rk[0]; *(LAS u32x4*)(lds + KS + t * 272 + cgp * 32 + 16) = R.rk[1];
        *(LAS u32x4*)(lds + vs + t * 144 + cgp * 16) = R.rv;
        f32x4 dc; dc[0] = bflo(R.rdec.x); dc[1] = bfhi(R.rdec.x); dc[2] = bflo(R.rdec.y); dc[3] = bfhi(R.rdec.y);
        asm volatile("" : "+v"(dc) :: "memory");
        gla_load(R, (n + 2 < 64) ? n + 2 : 63, t, hq, hv, pdec);
        LDS_BARRIER();
        { bf16x8 kf[4], qa[4], qb[4];
#pragma unroll
          for (int ks = 0; ks < 4; ++ks) { kf[ks] = frag_row(lds + KS, 272, 16 * jt, 32 * ks, idx, g); qa[ks] = frag_row(lds + qs, 272, 16 * it0, 32 * ks, idx, g); qb[ks] = frag_row(lds + qs, 272, 16 * it0 + 16, 32 * ks, idx, g); }
          asm volatile("s_waitcnt lgkmcnt(0)" ::: "memory");
          f32x4 aa = {0.f, 0.f, 0.f, 0.f}, ab = aa;
#pragma unroll
          for (int ks = 0; ks < 4; ++ks) { aa = mfma16(kf[ks], qa[ks], aa); ab = mfma16(kf[ks], qb[ks], ab); }
          const int j0 = 16 * jt + 4 * g, ia = 16 * it0 + idx, ib = ia + 16;
#pragma unroll
          for (int r = 0; r < 4; ++r) { aa[r] = (j0 + r <= ia) ? aa[r] : 0.f; ab[r] = (j0 + r <= ib) ? ab[r] : 0.f; }
          u32x2 wa, wb; wa.x = cvt_pk_bf16(aa[0], aa[1]); wa.y = cvt_pk_bf16(aa[2], aa[3]); wb.x = cvt_pk_bf16(ab[0], ab[1]); wb.y = cvt_pk_bf16(ab[2], ab[3]);
          *(LAS u32x2*)(lds + AS + ia * 144 + j0 * 2) = wa; *(LAS u32x2*)(lds + AS + ib * 144 + j0 * 2) = wb; }
        { const unsigned kaddr = lbase + KS + (unsigned)((8 * g + (idx >> 2)) * 272 + (16 * w + 4 * (idx & 3)) * 2);
          const unsigned vaddr = lbase + vs + (unsigned)((8 * g + (idx >> 2)) * 144 + (4 * (idx & 3)) * 2);
          s16x4 k00, k01, k10, k11, a0, a1, a2, a3, b0, b1, b2, b3, c0, c1, c2, c3, d0, d1, d2, d3;
          asm volatile(
              "ds_read_b64_tr_b16 %0, %20\n\tds_read_b64_tr_b16 %1, %20 offset:1088\n\tds_read_b64_tr_b16 %2, %20 offset:8704\n\tds_read_b64_tr_b16 %3, %20 offset:9792\n\t"
              "ds_read_b64_tr_b16 %4, %21\n\tds_read_b64_tr_b16 %5, %21 offset:32\n\tds_read_b64_tr_b16 %6, %21 offset:64\n\tds_read_b64_tr_b16 %7, %21 offset:96\n\t"
              "ds_read_b64_tr_b16 %8, %21 offset:576\n\tds_read_b64_tr_b16 %9, %21 offset:608\n\tds_read_b64_tr_b16 %10, %21 offset:640\n\tds_read_b64_tr_b16 %11, %21 offset:672\n\t"
              "ds_read_b64_tr_b16 %12, %21 offset:4608\n\tds_read_b64_tr_b16 %13, %21 offset:4640\n\tds_read_b64_tr_b16 %14, %21 offset:4672\n\tds_read_b64_tr_b16 %15, %21 offset:4704\n\t"
              "ds_read_b64_tr_b16 %16, %21 offset:5184\n\tds_read_b64_tr_b16 %17, %21 offset:5216\n\tds_read_b64_tr_b16 %18, %21 offset:5248\n\tds_read_b64_tr_b16 %19, %21 offset:5280\n\t"
              "s_waitcnt lgkmcnt(0)"
              : "=&v"(k00), "=&v"(k01), "=&v"(k10), "=&v"(k11), "=&v"(a0), "=&v"(a1), "=&v"(a2), "=&v"(a3), "=&v"(b0), "=&v"(b1), "=&v"(b2), "=&v"(b3),
                "=&v"(c0), "=&v"(c1), "=&v"(c2), "=&v"(c3), "=&v"(d0), "=&v"(d1), "=&v"(d2), "=&v"(d3)
              : "v"(kaddr), "v"(vaddr) : "memory");
          bf16x8 ka0, ka1, v0[4], v1[4];
          MKF(ka0, k00, k01) MKF(ka1, k10, k11)
          MKF(v0[0], a0, b0) MKF(v0[1], a1, b1) MKF(v0[2], a2, b2) MKF(v0[3], a3, b3)
          MKF(v1[0], c0, d0) MKF(v1[1], c1, d1) MKF(v1[2], c2, d2) MKF(v1[3], c3, d3)
#pragma unroll
          for (int dvt = 0; dvt < 4; ++dvt) { S[dvt] = mfma16(ka0, v0[dvt], S[dvt]); S[dvt] = mfma16(ka1, v1[dvt], S[dvt]); S[dvt] = S[dvt] * dc; }
#pragma unroll
          for (int dvt = 0; dvt < 4; ++dvt) { u32x2 wv; wv.x = cvt_pk_bf16(S[dvt][0], S[dvt][1]); wv.y = cvt_pk_bf16(S[dvt][2], S[dvt][3]);
              *(LAS u32x2*)(lds + stn + (16 * dvt + idx) * 272 + (16 * w + 4 * g) * 2) = wv; } }
        LDS_BARRIER();
        { const unsigned va = lbase + vs + (unsigned)((8 * g + (idx >> 2)) * 144 + (16 * jt + 4 * (idx & 3)) * 2);
          s16x4 x0, x1, y0, y1;
          asm volatile("ds_read_b64_tr_b16 %0, %4\n\tds_read_b64_tr_b16 %1, %4 offset:576\n\tds_read_b64_tr_b16 %2, %4 offset:4608\n\tds_read_b64_tr_b16 %3, %4 offset:5184"
                       : "=&v"(x0), "=&v"(x1), "=&v"(y0), "=&v"(y1) : "v"(va) : "memory");
          bf16x8 sf[4], qa[4], qb[4], a0f[2], a1f[2];
#pragma unroll
          for (int ks = 0; ks < 4; ++ks) { sf[ks] = frag_row(lds + stc, 272, 16 * jt, 32 * ks, idx, g); qa[ks] = frag_row(lds + qs, 272, 16 * it0, 32 * ks, idx, g); qb[ks] = frag_row(lds + qs, 272, 16 * it0 + 16, 32 * ks, idx, g); }
#pragma unroll
          for (int ks = 0; ks < 2; ++ks) { a0f[ks] = frag_row(lds + AS, 144, 16 * it0, 32 * ks, idx, g); a1f[ks] = frag_row(lds + AS, 144, 16 * it0 + 16, 32 * ks, idx, g); }
          asm volatile("s_waitcnt lgkmcnt(0)" : "+v"(x0), "+v"(x1), "+v"(y0), "+v"(y1) :: "memory");
          bf16x8 vf0, vf1;
          MKF(vf0, x0, x1) MKF(vf1, y0, y1)
          f32x4 oa = {0.f, 0.f, 0.f, 0.f}, ob = oa;
          oa = mfma16(vf0, a0f[0], oa); ob = mfma16(vf0, a1f[0], ob); oa = mfma16(vf1, a0f[1], oa); ob = mfma16(vf1, a1f[1], ob);
#pragma unroll
          for (int ks = 0; ks < 4; ++ks) { oa = mfma16(sf[ks], qa[ks], oa); ob = mfma16(sf[ks], qb[ks], ob); }
          u32x2 wa, wb; wa.x = cvt_pk_bf16(oa[0], oa[1]); wa.y = cvt_pk_bf16(oa[2], oa[3]); wb.x = cvt_pk_bf16(ob[0], ob[1]); wb.y = cvt_pk_bf16(ob[2], ob[3]);
          bf16_t* op = og + (size_t)(b * SEQ + n * 64 + 16 * it0 + idx) * 1024 + hh * 256 + sl * 64 + 16 * jt + 4 * g;
          *(u32x2*)op = wa; *(u32x2*)(op + 16 * 1024) = wb; }
      }
    }
    asm volatile("s_waitcnt vmcnt(0)" ::: "memory");
    __syncthreads();
}
#undef MKF

__device__ void dilated_item(const Params& p, int item, LAS unsigned char* lds) {
    const int tid = opaque_tid(), lane = tid & 63, w = __builtin_amdgcn_readfirstlane(tid >> 6), idx = lane & 15, g = lane >> 4;
    const int pat = item >> 10, rem = item & 1023, b = rem >> 8, head = (rem >> 5) & 7, sb = rem & 31;
    const int dsh = pat * 2, nbsh = 5 - dsh;
    const int r = sb >> nbsh, blk = sb & ((1 << nbsh) - 1);
    unsigned char* ws = p.ws;
    const bf16_t* hb = (const bf16_t*)(ws + OFF_H) + (size_t)(b * SEQ) * HC;
    const unsigned lbase = (unsigned)(size_t)lds;
    { const int piece = tid & 15;
#pragma unroll
      for (int it = 0; it < 8; ++it) {
          const int row = (tid >> 4) + 32 * it, lj = (blk - 1) * 128 + row;
          u32x4 kv = {0u, 0u, 0u, 0u}, vv = kv;
          if (lj >= 0) { const int pos = r + (lj << dsh); const bf16_t* rp = hb + (size_t)pos * HC + head * 128 + piece * 8; kv = *(const u32x4*)(rp + 4096); vv = *(const u32x4*)(rp + 5120); }
          *(LAS u32x4*)(lds + row * KV_STRIDE + piece * 16) = kv; *(LAS u32x4*)(lds + KV_BUF + row * KV_STRIDE + piece * 16) = vv;
      } }
    const int qpos = r + ((blk * 128 + 16 * w + idx) << dsh);
    bf16x8 qf[4];
    { const bf16_t* qp = hb + (size_t)qpos * HC + 3072 + head * 128 + 8 * g;
#pragma unroll
      for (int ks = 0; ks < 4; ++ks) qf[ks] = *(const bf16x8*)(qp + 32 * ks); }
    __syncthreads();
    f32x4 sc[9];
#pragma unroll
    for (int tt = 0; tt < 9; ++tt) {
        sc[tt] = (f32x4){0.f, 0.f, 0.f, 0.f};
#pragma unroll
        for (int ks = 0; ks < 4; ++ks) sc[tt] = mfma16(frag_row(lds, KV_STRIDE, 16 * (w + tt), 32 * ks, idx, g), qf[ks], sc[tt]);
    }
    const int qi = 128 + 16 * w + idx;
    float mx = -1e30f;
#pragma unroll
    for (int tt = 0; tt < 9; ++tt)
#pragma unroll
        for (int rr = 0; rr < 4; ++rr) {
            const int kj = 16 * (w + tt) + 4 * g + rr, diff = qi - kj;
            const bool valid = (diff >= 0) && (diff <= 128) && (blk > 0 || kj >= 128);
            const float s = valid ? sc[tt][rr] * LOG2E : -1e30f;
            sc[tt][rr] = s; mx = fmaxf(mx, s);
        }
    mx = fmaxf(mx, __shfl_xor(mx, 16)); mx = fmaxf(mx, __shfl_xor(mx, 32));
    float sum = 0.f;
#pragma unroll
    for (int tt = 0; tt < 9; ++tt)
#pragma unroll
        for (int rr = 0; rr < 4; ++rr) { const float e = fexp2(sc[tt][rr] - mx); sc[tt][rr] = e; sum += e; }
    sum += __shfl_xor(sum, 16); sum += __shfl_xor(sum, 32);
    f32x4 ot[8];
#pragma unroll
    for (int c = 0; c < 8; ++c) ot[c] = (f32x4){0.f, 0.f, 0.f, 0.f};
#pragma unroll
    for (int s5 = 0; s5 < 5; ++s5) {
        const int ta = w + 2 * s5, tb = (s5 < 4) ? ta + 1 : ta;
        u32x4 pw; pw.x = cvt_pk_bf16(sc[2 * s5][0], sc[2 * s5][1]); pw.y = cvt_pk_bf16(sc[2 * s5][2], sc[2 * s5][3]);
        if (s5 < 4) { pw.z = cvt_pk_bf16(sc[(2 * s5 + 1) % 9][0], sc[(2 * s5 + 1) % 9][1]); pw.w = cvt_pk_bf16(sc[(2 * s5 + 1) % 9][2], sc[(2 * s5 + 1) % 9][3]); } else { pw.z = 0u; pw.w = 0u; }
        const bf16x8 pf = __builtin_bit_cast(bf16x8, pw);
        const unsigned aA = lbase + KV_BUF + (unsigned)((16 * ta + 4 * g + (idx >> 2)) * KV_STRIDE + 8 * (idx & 3));
        const unsigned aB = lbase + KV_BUF + (unsigned)((16 * tb + 4 * g + (idx >> 2)) * KV_STRIDE + 8 * (idx & 3));
        bf16x8 vf[4];
        tr_frag4(aA, aB, vf);
#pragma unroll
        for (int c = 0; c < 4; ++c) ot[c] = mfma16(vf[c], pf, ot[c]);
        tr_frag4(aA + 128, aB + 128, vf);
#pragma unroll
        for (int c = 0; c < 4; ++c) ot[4 + c] = mfma16(vf[c], pf, ot[4 + c]);
    }
    const float inv = 1.0f / sum;
    const size_t tok = (size_t)(b * SEQ + qpos);
    bf16_t* od = (bf16_t*)(ws + (pat == 0 ? OFF_B2 : (pat == 1 ? OFF_B2 + 32 * MiB : OFF_OD2)));
#pragma unroll
    for (int c = 0; c < 8; ++c) { u32x2 wv; wv.x = cvt_pk_bf16(ot[c][0] * inv, ot[c][1] * inv); wv.y = cvt_pk_bf16(ot[c][2] * inv, ot[c][3] * inv);
        *(u32x2*)(od + tok * 1024 + head * 128 + 16 * c + 4 * g) = wv; }
    if (g == 0) ((float*)(ws + OFF_LSE))[(size_t)pat * T_TOK * 8 + tok * 8 + head] = (mx + flog2(sum)) * LN2;
    __syncthreads();
}

__device__ void cross_items(const Params& p, LAS unsigned char* lds) {
    const int tid = opaque_tid(), lane = tid & 63, w = __builtin_amdgcn_readfirstlane(tid >> 6), idx = lane & 15, g = lane >> 4;
    unsigned char* ws = p.ws;
    bf16_t* oc = (bf16_t*)(ws + OFF_OC);
    const unsigned lbase = (unsigned)(size_t)lds;
    const int piece = tid & 15, srow = tid >> 4;
    const int G = (int)gridDim.x;
    u32x4 pre[8];
#define XLOAD(kvbase, c8) do { const bf16_t* _src = (kvbase) + (((c8) >= 4) ? 2048 : 0) + ((c8) & 3) * 128 + piece * 8; \
        _Pragma("unroll") for (int _it = 0; _it < 8; ++_it) pre[_it] = *(const u32x4*)(_src + (size_t)(srow + 32 * _it) * 4096); } while (0)
#define XSTORE(buf) do { _Pragma("unroll") for (int _it = 0; _it < 8; ++_it) *(LAS u32x4*)((buf) + (srow + 32 * _it) * KV_STRIDE + piece * 16) = pre[_it]; } while (0)
    int item = (int)blockIdx.x;
    if (item < 512) { const bf16_t* kvb0 = (const bf16_t*)(ws + OFF_MKV) + (size_t)((item >> 7) * 256) * 4096 + ((item >> 5) & 3) * 512; XLOAD(kvb0, 0); }
    for (; item < 512; item += G) {
        const int b = item >> 7, head = (item >> 5) & 3, qb = item & 31;
        const size_t tok = (size_t)(b * SEQ + qb * 128 + 16 * w + idx);
        const bf16_t* qrow = (const bf16_t*)(ws + OFF_B1) + tok * DM + head * 512 + 8 * g;
        const bf16_t* kvb = (const bf16_t*)(ws + OFF_MKV) + (size_t)(b * 256) * 4096 + head * 512;
        f32x4 sc[16];
#pragma unroll
        for (int kt = 0; kt < 16; ++kt) sc[kt] = (f32x4){0.f, 0.f, 0.f, 0.f};
        for (int c = 0; c < 4; ++c) {
            LAS unsigned char* buf = lds + (c & 1) * KV_BUF;
            XSTORE(buf);
            bf16x8 qf[4];
#pragma unroll
            for (int ks = 0; ks < 4; ++ks) qf[ks] = *(const bf16x8*)(qrow + c * 128 + 32 * ks);
            XLOAD(kvb, c + 1);
            LDS_BARRIER();
#pragma unroll
            for (int kt = 0; kt < 16; ++kt)
#pragma unroll
                for (int ks = 0; ks < 4; ++ks) sc[kt] = mfma16(frag_row(buf, KV_STRIDE, 16 * kt, 32 * ks, idx, g), qf[ks], sc[kt]);
        }
        const float scl = 0.04419417382415922f * LOG2E;
        float mx = -1e30f;
#pragma unroll
        for (int kt = 0; kt < 16; ++kt)
#pragma unroll
            for (int rr = 0; rr < 4; ++rr) { const float sv = sc[kt][rr] * scl; sc[kt][rr] = sv; mx = fmaxf(mx, sv); }
        mx = fmaxf(mx, __shfl_xor(mx, 16)); mx = fmaxf(mx, __shfl_xor(mx, 32));
        float sum = 0.f;
#pragma unroll
        for (int kt = 0; kt < 16; ++kt)
#pragma unroll
            for (int rr = 0; rr < 4; ++rr) { const float e = fexp2(sc[kt][rr] - mx); sc[kt][rr] = e; sum += e; }
        sum += __shfl_xor(sum, 16); sum += __shfl_xor(sum, 32);
        const float inv = 1.0f / sum;
        bf16x8 pf[8];
#pragma unroll
        for (int sx = 0; sx < 8; ++sx) { u32x4 pw; pw.x = cvt_pk_bf16(sc[2 * sx][0], sc[2 * sx][1]); pw.y = cvt_pk_bf16(sc[2 * sx][2], sc[2 * sx][3]); pw.z = cvt_pk_bf16(sc[2 * sx + 1][0], sc[2 * sx + 1][1]); pw.w = cvt_pk_bf16(sc[2 * sx + 1][2], sc[2 * sx + 1][3]);
            pf[sx] = __builtin_bit_cast(bf16x8, pw); }
        const int nitem = item + G;
        const bf16_t* nkvb = (const bf16_t*)(ws + OFF_MKV) + (size_t)(((nitem < 512 ? nitem : item) >> 7) * 256) * 4096 + (((nitem < 512 ? nitem : item) >> 5) & 3) * 512;
        for (int c = 0; c < 4; ++c) {
            LAS unsigned char* buf = lds + (c & 1) * KV_BUF;
            XSTORE(buf);
            if (c < 3) XLOAD(kvb, 5 + c); else XLOAD(nkvb, 0);
            LDS_BARRIER();
            f32x4 ot[8];
#pragma unroll
            for (int c8 = 0; c8 < 8; ++c8) ot[c8] = (f32x4){0.f, 0.f, 0.f, 0.f};
            const unsigned bb = lbase + (unsigned)((c & 1) * KV_BUF);
#pragma unroll
            for (int sx = 0; sx < 8; ++sx) {
                const unsigned aA = bb + (unsigned)((32 * sx + 4 * g + (idx >> 2)) * KV_STRIDE + 8 * (idx & 3));
                const unsigned aB = aA + 16u * KV_STRIDE;
                bf16x8 vf[4];
                tr_frag4(aA, aB, vf);
#pragma unroll
                for (int c8 = 0; c8 < 4; ++c8) ot[c8] = mfma16(vf[c8], pf[sx], ot[c8]);
                tr_frag4(aA + 128, aB + 128, vf);
#pragma unroll
                for (int c8 = 0; c8 < 4; ++c8) ot[4 + c8] = mfma16(vf[c8], pf[sx], ot[4 + c8]);
            }
#pragma unroll
            for (int c8 = 0; c8 < 8; ++c8) { u32x2 wv; wv.x = cvt_pk_bf16(ot[c8][0] * inv, ot[c8][1] * inv); wv.y = cvt_pk_bf16(ot[c8][2] * inv, ot[c8][3] * inv);
                *(u32x2*)(oc + tok * DM + head * 512 + c * 128 + 16 * c8 + 4 * g) = wv; }
        }
    }
#undef XLOAD
#undef XSTORE
    asm volatile("s_waitcnt vmcnt(0)" ::: "memory");
    __syncthreads();
}

__device__ void merge_phase(const Params& p) {
    const int tid_ = opaque_tid(); const int lane = tid_ & 63, wid = tid_ >> 6;
    unsigned char* ws = p.ws;
    const bf16_t* og = (const bf16_t*)(ws + OFF_OG); const bf16_t* h = (const bf16_t*)(ws + OFF_H);
    const bf16_t* od0 = (const bf16_t*)(ws + OFF_B2); const bf16_t* od1 = (const bf16_t*)(ws + OFF_B2 + 32 * MiB); const bf16_t* od2 = (const bf16_t*)(ws + OFF_OD2);
    const float* lse = (const float*)(ws + OFF_LSE);
    bf16_t* mix = (bf16_t*)(ws + OFF_B1);
    for (int tok = blockIdx.x * 8 + wid; tok < T_TOK; tok += gridDim.x * 8) {
        { const int hh = lane >> 4, sub = lane & 15;
          const bf16_t* src = og + (size_t)tok * 1024 + hh * 256 + sub * 16;
          const u32x4 a = *(const u32x4*)src, b = *(const u32x4*)(src + 8);
          float xv[16];
#pragma unroll
          for (int j = 0; j < 4; ++j) { xv[2 * j] = bflo(a[j]); xv[2 * j + 1] = bfhi(a[j]); xv[8 + 2 * j] = bflo(b[j]); xv[8 + 2 * j + 1] = bfhi(b[j]); }
          float s = 0.f;
#pragma unroll
          for (int j = 0; j < 16; ++j) s += xv[j];
          s += __shfl_xor(s, 1); s += __shfl_xor(s, 2); s += __shfl_xor(s, 4); s += __shfl_xor(s, 8);
          const float mean = s * (1.0f / 256.0f);
          float q = 0.f;
#pragma unroll
          for (int j = 0; j < 16; ++j) { const float dlt = xv[j] - mean; q += dlt * dlt; }
          q += __shfl_xor(q, 1); q += __shfl_xor(q, 2); q += __shfl_xor(q, 4); q += __shfl_xor(q, 8);
          const float rstd = rsqrtf(q * (1.0f / 256.0f) + 1e-5f);
          const bf16_t* rgp = h + (size_t)tok * HC + 2048 + hh * 256 + sub * 16;
          const u32x4 ra = *(const u32x4*)rgp, rb = *(const u32x4*)(rgp + 8);
          const float* ngp = p.norm_g + hh * 256 + sub * 16;
          float ov[16];
#pragma unroll
          for (int j4 = 0; j4 < 4; ++j4) { const f32x4 ng = *(const f32x4*)(ngp + 4 * j4);
#pragma unroll
              for (int j = 0; j < 4; ++j) { const int e = 4 * j4 + j; const unsigned rw = (e < 8) ? ra[e >> 1] : rb[(e - 8) >> 1]; const float rv = (e & 1) ? bfhi(rw) : bflo(rw);
                  ov[e] = (xv[e] - mean) * rstd * ng[j] * silu_f(rv); } }
          u32x4 o0, o1;
#pragma unroll
          for (int j = 0; j < 4; ++j) { o0[j] = cvt_pk_bf16(ov[2 * j], ov[2 * j + 1]); o1[j] = cvt_pk_bf16(ov[8 + 2 * j], ov[8 + 2 * j + 1]); }
          bf16_t* dst = mix + (size_t)tok * DM + hh * 256 + sub * 16;
          *(u32x4*)dst = o0; *(u32x4*)(dst + 8) = o1; }
        { const int hd = lane >> 3, sub = lane & 7;
          const float l0 = lse[(size_t)tok * 8 + hd], l1 = lse[(size_t)T_TOK * 8 + (size_t)tok * 8 + hd], l2 = lse[(size_t)2 * T_TOK * 8 + (size_t)tok * 8 + hd];
          const float m = fmaxf(l0, fmaxf(l1, l2));
          float e0 = fexp2((l0 - m) * LOG2E), e1 = fexp2((l1 - m) * LOG2E), e2 = fexp2((l2 - m) * LOG2E);
          const float inv = 1.0f / (e0 + e1 + e2); e0 *= inv; e1 *= inv; e2 *= inv;
          const size_t so = (size_t)tok * 1024 + hd * 128 + sub * 16;
          u32x4 o[2];
#pragma unroll
          for (int hf = 0; hf < 2; ++hf) { const u32x4 a = *(const u32x4*)(od0 + so + 8 * hf), b = *(const u32x4*)(od1 + so + 8 * hf), c = *(const u32x4*)(od2 + so + 8 * hf);
#pragma unroll
              for (int j = 0; j < 4; ++j) o[hf][j] = cvt_pk_bf16(e0 * bflo(a[j]) + e1 * bflo(b[j]) + e2 * bflo(c[j]), e0 * bfhi(a[j]) + e1 * bfhi(b[j]) + e2 * bfhi(c[j])); }
          bf16_t* dst = mix + (size_t)tok * DM + 1024 + hd * 128 + sub * 16;
          *(u32x4*)dst = o[0]; *(u32x4*)(dst + 8) = o[1]; }
    }
}

__device__ void ln_phase(float* io, const float* __restrict__ gam, const float* __restrict__ bet, bf16_t* ob) {
    const int tid_ = opaque_tid(); const int lane = tid_ & 63, wid = tid_ >> 6;
    for (int row = blockIdx.x * 8 + wid; row < T_TOK; row += gridDim.x * 8) {
        float* pr = io + (size_t)row * DM + lane * 4;
        f32x4 v[8]; float s = 0.f;
#pragma unroll
        for (int j = 0; j < 8; ++j) { v[j] = *(const f32x4*)(pr + 256 * j); s += (v[j][0] + v[j][1]) + (v[j][2] + v[j][3]); }
#pragma unroll
        for (int o = 32; o; o >>= 1) s += __shfl_xor(s, o);
        const float mean = s * (1.0f / 2048.0f);
        float q = 0.f;
#pragma unroll
        for (int j = 0; j < 8; ++j) { const f32x4 dlt = v[j] - mean; q += (dlt[0] * dlt[0] + dlt[1] * dlt[1]) + (dlt[2] * dlt[2] + dlt[3] * dlt[3]); }
#pragma unroll
        for (int o = 32; o; o >>= 1) q += __shfl_xor(q, o);
        const float rstd = rsqrtf(q * (1.0f / 2048.0f) + 1e-5f);
#pragma unroll
        for (int j = 0; j < 8; ++j) {
            const f32x4 gv = *(const f32x4*)(gam + lane * 4 + 256 * j), bv = *(const f32x4*)(bet + lane * 4 + 256 * j);
            const f32x4 y = (v[j] - mean) * rstd * gv + bv;
            if (!ob) *(f32x4*)(pr + 256 * j) = y;
            if (ob) { u32x2 wv; wv.x = cvt_pk_bf16(y[0], y[1]); wv.y = cvt_pk_bf16(y[2], y[3]); *(u32x2*)(ob + (size_t)row * DM + lane * 4 + 256 * j) = wv; }
        }
    }
}


__device__ void ln_phase2(const bf16_t* __restrict__ mix, const float* __restrict__ Rf, const bf16_t* __restrict__ Rb, const float* __restrict__ gam, const float* __restrict__ bet, bf16_t* ob, float* of) {
    const int tid_ = opaque_tid(); const int lane = tid_ & 63, wid = tid_ >> 6;
    for (int row = blockIdx.x * 8 + wid; row < T_TOK; row += gridDim.x * 8) {
        const size_t ro = (size_t)row * DM + lane * 8;
        float v[32]; float s = 0.f;
#pragma unroll
        for (int j = 0; j < 4; ++j) {
            const u32x4 m = *(const u32x4*)(mix + ro + 512 * j);
            float r[8];
            if (Rf) { const f32x4 a = *(const f32x4*)(Rf + ro + 512 * j), b = *(const f32x4*)(Rf + ro + 512 * j + 4);
                r[0] = a[0]; r[1] = a[1]; r[2] = a[2]; r[3] = a[3]; r[4] = b[0]; r[5] = b[1]; r[6] = b[2]; r[7] = b[3]; }
            else { const u32x4 rb = *(const u32x4*)(Rb + ro + 512 * j);
                r[0] = bflo(rb.x); r[1] = bfhi(rb.x); r[2] = bflo(rb.y); r[3] = bfhi(rb.y); r[4] = bflo(rb.z); r[5] = bfhi(rb.z); r[6] = bflo(rb.w); r[7] = bfhi(rb.w); }
            v[8 * j + 0] = DN_ALPHA * r[0] + bflo(m.x); v[8 * j + 1] = DN_ALPHA * r[1] + bfhi(m.x); v[8 * j + 2] = DN_ALPHA * r[2] + bflo(m.y); v[8 * j + 3] = DN_ALPHA * r[3] + bfhi(m.y);
            v[8 * j + 4] = DN_ALPHA * r[4] + bflo(m.z); v[8 * j + 5] = DN_ALPHA * r[5] + bfhi(m.z); v[8 * j + 6] = DN_ALPHA * r[6] + bflo(m.w); v[8 * j + 7] = DN_ALPHA * r[7] + bfhi(m.w);
#pragma unroll
            for (int e = 0; e < 8; ++e) s += v[8 * j + e];
        }
#pragma unroll
        for (int o = 32; o; o >>= 1) s += __shfl_xor(s, o);
        const float mean = s * (1.0f / 2048.0f);
        float q = 0.f;
#pragma unroll
        for (int e = 0; e < 32; ++e) { const float dlt = v[e] - mean; q += dlt * dlt; }
#pragma unroll
        for (int o = 32; o; o >>= 1) q += __shfl_xor(q, o);
        const float rstd = rsqrtf(q * (1.0f / 2048.0f) + 1e-5f);
#pragma unroll
        for (int j = 0; j < 4; ++j) {
            const f32x4 g0 = *(const f32x4*)(gam + lane * 8 + 512 * j), g1 = *(const f32x4*)(gam + lane * 8 + 512 * j + 4);
            const f32x4 b0 = *(const f32x4*)(bet + lane * 8 + 512 * j), b1 = *(const f32x4*)(bet + lane * 8 + 512 * j + 4);
            f32x4 y0, y1;
#pragma unroll
            for (int e = 0; e < 4; ++e) { y0[e] = (v[8 * j + e] - mean) * rstd * g0[e] + b0[e]; y1[e] = (v[8 * j + 4 + e] - mean) * rstd * g1[e] + b1[e]; }
            if (ob) { u32x4 w; w.x = cvt_pk_bf16(y0[0], y0[1]); w.y = cvt_pk_bf16(y0[2], y0[3]); w.z = cvt_pk_bf16(y1[0], y1[1]); w.w = cvt_pk_bf16(y1[2], y1[3]); *(u32x4*)(ob + ro + 512 * j) = w; }
            else { *(f32x4*)(of + ro + 512 * j) = y0; *(f32x4*)(of + ro + 512 * j + 4) = y1; }
        }
    }
}

__device__ void conv_phase(const Params& p, int half) {
    unsigned char* ws = p.ws;
    const bf16_t* u = (const bf16_t*)(ws + OFF_U); bf16_t* gout = (bf16_t*)(ws + OFF_G);
    constexpr int NCG = DFF / 8;
    for (int task = blockIdx.x * 512 + opaque_tid(); task < 512 * NCG; task += gridDim.x * 512) {
        const int cgp = task % NCG, tb = task / NCG, c = cgp * 8, r0 = tb * 16, t0 = half * 8192 + r0;
        float wg[3][8], wu[3][8], bg[8], bu[8];
#pragma unroll
        for (int i = 0; i < 3; ++i)
#pragma unroll
            for (int j4 = 0; j4 < 2; ++j4) { const f32x4 a = *(const f32x4*)(p.conv_w + (size_t)i * 11008 + c + 4 * j4), b = *(const f32x4*)(p.conv_w + (size_t)i * 11008 + DFF + c + 4 * j4);
#pragma unroll
                for (int j = 0; j < 4; ++j) { wg[i][4 * j4 + j] = a[j]; wu[i][4 * j4 + j] = b[j]; } }
#pragma unroll
        for (int j4 = 0; j4 < 2; ++j4) { const f32x4 a = *(const f32x4*)(p.conv_b + c + 4 * j4), b = *(const f32x4*)(p.conv_b + DFF + c + 4 * j4);
#pragma unroll
            for (int j = 0; j < 4; ++j) { bg[4 * j4 + j] = a[j]; bu[4 * j4 + j] = b[j]; } }
        float g2[8], g1[8], u2[8], u1[8];
        if ((t0 & (SEQ - 1)) == 0) {
#pragma unroll
            for (int j = 0; j < 8; ++j) { g2[j] = 0.f; g1[j] = 0.f; u2[j] = 0.f; u1[j] = 0.f; }
        } else {
            const u32x4 a2 = *(const u32x4*)(u + (size_t)(r0 - 2) * 11008 + c), a1 = *(const u32x4*)(u + (size_t)(r0 - 1) * 11008 + c);
            const u32x4 b2 = *(const u32x4*)(u + (size_t)(r0 - 2) * 11008 + DFF + c), b1 = *(const u32x4*)(u + (size_t)(r0 - 1) * 11008 + DFF + c);
#pragma unroll
            for (int j = 0; j < 4; ++j) { g2[2 * j] = bflo(a2[j]); g2[2 * j + 1] = bfhi(a2[j]); g1[2 * j] = bflo(a1[j]); g1[2 * j + 1] = bfhi(a1[j]);
                u2[2 * j] = bflo(b2[j]); u2[2 * j + 1] = bfhi(b2[j]); u1[2 * j] = bflo(b1[j]); u1[2 * j + 1] = bfhi(b1[j]); }
        }
#pragma unroll 2
        for (int rr = 0; rr < 16; ++rr) {
            const u32x4 a0 = *(const u32x4*)(u + (size_t)(r0 + rr) * 11008 + c), b0 = *(const u32x4*)(u + (size_t)(r0 + rr) * 11008 + DFF + c);
            float gc[8], uc[8], res[8];
#pragma unroll
            for (int j = 0; j < 4; ++j) { gc[2 * j] = bflo(a0[j]); gc[2 * j + 1] = bfhi(a0[j]); uc[2 * j] = bflo(b0[j]); uc[2 * j + 1] = bfhi(b0[j]); }
#pragma unroll
            for (int j = 0; j < 8; ++j) {
                const float yg = bg[j] + wg[0][j] * g2[j] + wg[1][j] * g1[j] + wg[2][j] * gc[j];
                const float yu = bu[j] + wu[0][j] * u2[j] + wu[1][j] * u1[j] + wu[2][j] * uc[j];
                res[j] = silu_f(yg) * yu;
                g2[j] = g1[j]; g1[j] = gc[j]; u2[j] = u1[j]; u1[j] = uc[j];
            }
            u32x4 o; o.x = cvt_pk_bf16(res[0], res[1]); o.y = cvt_pk_bf16(res[2], res[3]); o.z = cvt_pk_bf16(res[4], res[5]); o.w = cvt_pk_bf16(res[6], res[7]);
            *(u32x4*)(gout + (size_t)(t0 + rr) * DFF + c) = o;
        }
    }
}


__device__ void conv_fixup(const Params& p) {
    unsigned char* ws = p.ws;
    const float* hu = (const float*)(ws + OFF_U); bf16_t* gout = (bf16_t*)(ws + OFF_G);
    for (int task = blockIdx.x * 512 + opaque_tid(); task < 128 * DFF; task += gridDim.x * 512) {
        const int bd = task / DFF, c = task - bd * DFF, pm = bd >> 1, hb = bd & 1;
        if (hb == 0 && (pm & 15) == 0) continue;
        const int rp = (hb == 0) ? ((pm - 1) * 8 + 6) : (pm * 8 + 2), rc = pm * 8 + 4 * hb;
        float ug[4], uu[4];
        ug[0] = hu[((size_t)((rp + 0) * 2 + 0)) * DFF + c]; ug[1] = hu[((size_t)((rp + 1) * 2 + 0)) * DFF + c];
        ug[2] = hu[((size_t)((rc + 0) * 2 + 0)) * DFF + c]; ug[3] = hu[((size_t)((rc + 1) * 2 + 0)) * DFF + c];
        uu[0] = hu[((size_t)((rp + 0) * 2 + 1)) * DFF + c]; uu[1] = hu[((size_t)((rp + 1) * 2 + 1)) * DFF + c];
        uu[2] = hu[((size_t)((rc + 0) * 2 + 1)) * DFF + c]; uu[3] = hu[((size_t)((rc + 1) * 2 + 1)) * DFF + c];
        const float wg0 = p.conv_w[c], wg1 = p.conv_w[11008 + c], wg2 = p.conv_w[22016 + c], wu0 = p.conv_w[DFF + c], wu1 = p.conv_w[11008 + DFF + c], wu2 = p.conv_w[22016 + DFF + c];
        const float bg = p.conv_b[c], bu = p.conv_b[DFF + c];
#pragma unroll
        for (int e = 0; e < 2; ++e) {
            const float yg = bg + wg0 * ug[e] + wg1 * ug[e + 1] + wg2 * ug[e + 2];
            const float yu = bu + wu0 * uu[e] + wu1 * uu[e + 1] + wu2 * uu[e + 2];
            const float r = silu_f(yg) * yu;
            gout[(size_t)(pm * 256 + 128 * hb + e) * DFF + c] = (bf16_t)(cvt_pk_bf16(r, r) & 0xffffu);
        }
    }
}

#define XB_TMO      128
#define XB_XCNT(j)  (256  + 64 * (j))
#define XB_XSUB(j)  (1280 + 64 * (j))
#define XB_XGEN(j)  (2304 + 64 * (j))
#define XB_TOP      3328
#define XB_TOPGEN   3392
#define XCD_BAR_WORDS 3456
#define XB_SPIN_CAP (1u << 22)
__device__ __forceinline__ unsigned xb_ld(unsigned* p)              { return __hip_atomic_load(p, __ATOMIC_RELAXED, __HIP_MEMORY_SCOPE_AGENT); }
__device__ __forceinline__ unsigned xb_add(unsigned* p, unsigned v) { return __hip_atomic_fetch_add(p, v, __ATOMIC_RELAXED, __HIP_MEMORY_SCOPE_AGENT); }
__device__ __forceinline__ unsigned xb_xcc_id() { return (unsigned)__builtin_amdgcn_s_getreg((3 << 11) | 20) & 0xFu; }
#define XB_SPIN(cond, bar) do { unsigned _sp = 0; while (cond) { __builtin_amdgcn_s_sleep(1); \
    if ((++_sp & 255u) == 0u) { if (xb_ld(&(bar)[XB_TMO])) break; if (_sp > XB_SPIN_CAP) { atomicAdd(&(bar)[XB_TMO], 1u); break; } } } } while (0)
struct XcdBarrier { unsigned* bar; unsigned x; volatile LAS unsigned* st; };
__device__ __forceinline__ XcdBarrier xcd_barrier_post(unsigned* bar, volatile LAS unsigned* st) {
    XcdBarrier b; b.bar = bar; b.x = xb_xcc_id(); b.st = st;
    if (threadIdx.x == 0) (void)xb_add(&bar[XB_XCNT(b.x)], 1u);
    return b;
}
__device__ __forceinline__ void xcd_barrier_complete(unsigned* bar, unsigned x, unsigned& nloc, unsigned& nx) {
    const unsigned G = gridDim.x * gridDim.y * gridDim.z;
    unsigned sum, cnt, mine, sp = 0u;
    for (;;) {
        sum = 0u; cnt = 0u; mine = 0u;
#pragma unroll
        for (unsigned j = 0; j < 16; ++j) { const unsigned c = xb_ld(&bar[XB_XCNT(j)]); sum += c; cnt += (c > 0u) ? 1u : 0u; mine = (j == x) ? c : mine; }
        if (sum == G) break;
        __builtin_amdgcn_s_sleep(1);
        if ((++sp & 255u) == 0u) { if (xb_ld(&bar[XB_TMO])) break; if (sp > XB_SPIN_CAP) { atomicAdd(&bar[XB_TMO], 1u); break; } }
    }
    nloc = mine > 0u ? mine : 1u; nx = cnt > 0u ? cnt : 1u;
}
__device__ __forceinline__ void xcd_barrier(const XcdBarrier& b) {
    asm volatile("s_waitcnt vmcnt(0)" ::: "memory");
    __syncthreads();
    if (threadIdx.x == 0) {
        unsigned* bar = b.bar;
        __builtin_amdgcn_s_waitcnt(0);
        unsigned nloc = b.st[0], nx = b.st[1];
        if (nloc == 0u) { xcd_barrier_complete(bar, b.x, nloc, nx); b.st[0] = nloc; b.st[1] = nx; }
        const unsigned old = xb_add(&bar[XB_XSUB(b.x)], 1u);
        const unsigned gen = old / nloc;
        if (old + 1u == (gen + 1u) * nloc) {
            __builtin_amdgcn_fence(__ATOMIC_RELEASE, "agent");
            asm volatile("s_waitcnt vmcnt(0)" ::: "memory");
            const unsigned og = xb_add(&bar[XB_TOP], 1u);
            const unsigned tg = og / nx;
            if (og + 1u == (tg + 1u) * nx) xb_add(&bar[XB_TOPGEN], 1u);
            else XB_SPIN(xb_ld(&bar[XB_TOPGEN]) == tg, bar);
            __builtin_amdgcn_fence(__ATOMIC_ACQUIRE, "agent");
            xb_add(&bar[XB_XGEN(b.x)], 1u);
            asm volatile("s_waitcnt vmcnt(0)" ::: "memory");
        } else {
            XB_SPIN(xb_ld(&bar[XB_XGEN(b.x)]) == gen, bar);
            __builtin_amdgcn_fence(__ATOMIC_ACQUIRE, "agent");
            asm volatile("s_waitcnt vmcnt(0)" ::: "memory");
        }
    }
    __syncthreads();
}

constexpr int NPHASE = 14;
#ifndef REP_PH
#define REP_PH -1
#endif
#ifndef REP_SYNC
#define REP_SYNC 1
#endif
#ifndef REP_MODE
#define REP_MODE 0
#endif
#ifndef PHMASK
#define PHMASK 0xFFFFF
#endif
#define EN(x) (((PHMASK) >> (x)) & 1)
__global__ void __launch_bounds__(512, 2) fwd_megakernel(Params p) {
    extern __shared__ __attribute__((aligned(16))) unsigned char smem[];
    LAS unsigned char* lds = (LAS unsigned char*)smem;
    cg::grid_group grid = cg::this_grid();
    unsigned char* ws = p.ws;
    const int G = (int)gridDim.x, bid = (int)blockIdx.x;
    if (threadIdx.x < 2) *(LAS unsigned*)(lds + LDS_SLOT + 16 + 4 * threadIdx.x) = 0u;
    __syncthreads();
    const XcdBarrier xb = xcd_barrier_post((unsigned*)(ws + OFF_BAR), (volatile LAS unsigned*)(lds + LDS_SLOT + 16));
    if (p.ph_lo < 0) grid.sync();
    for (int ph = p.ph_lo; ph < p.ph_hi; ++ph) {
      for (int rep = 0; rep < ((ph == REP_PH) ? 2 : 1); ++rep) {
        GemmDesc gd; gd.M = 0; gd.R = nullptr; gd.rope = nullptr; gd.G = G; gd.c = bid; gd.rbf = 0; gd.aux = nullptr; gd.mode = 0; gd.A = nullptr; gd.Bt = nullptr; gd.C = nullptr; gd.N = 0; gd.K = 0; gd.ldc = 0;
        switch (ph) {
        case 0: if (EN(0)) prep_phase(p, smem); break;
        case 1: gd.A = (const bf16_t*)(ws + OFF_B1); gd.Bt = (const bf16_t*)(ws + OFF_WIN); gd.C = ws + OFF_H; gd.rope = (const float*)(ws + OFF_ROPE); gd.aux = (float*)(ws + OFF_EB); gd.M = T_TOK; gd.N = HC; gd.K = DM; gd.ldc = HC; gd.mode = 1; break;
        case 2:
            if (bid < 64) { if (EN(1) && !(rep == 1 && REP_MODE == 2)) gla_item(p, bid, lds); }
            else if (bid < 128 && !(rep == 1 && REP_MODE != 0)) { gd.A = (const bf16_t*)(ws + OFF_MEMB); gd.Bt = (const bf16_t*)(ws + OFF_WKV); gd.C = ws + OFF_MKV; gd.M = 1024; gd.N = 4096; gd.K = DM; gd.ldc = 4096; gd.mode = 0; gd.G = 64; gd.c = bid - 64; }
            break;
        case 3: if (EN(2)) merge_phase(p); break;
        case 4: gd.A = (const bf16_t*)(ws + OFF_B1); gd.Bt = (const bf16_t*)(ws + OFF_WOUT); gd.C = ws + OFF_MIX4; gd.M = T_TOK; gd.N = DM; gd.K = DM; gd.ldc = DM; gd.mode = 0; break;
        case 5: if (EN(3)) ln_phase2((const bf16_t*)(ws + OFF_MIX4), p.x, nullptr, p.ln1_g, p.ln1_b, (bf16_t*)(ws + OFF_X1B), nullptr); break;
        case 6: gd.A = (const bf16_t*)(ws + OFF_X1B); gd.Bt = (const bf16_t*)(ws + OFF_WQ); gd.C = ws + OFF_B1; gd.M = T_TOK; gd.N = DM; gd.K = DM; gd.ldc = DM; gd.mode = 0; break;
        case 7: if (EN(4)) cross_items(p, lds); break;
        case 8: gd.A = (const bf16_t*)(ws + OFF_OC); gd.Bt = (const bf16_t*)(ws + OFF_WO); gd.C = ws + OFF_MIX8; gd.M = T_TOK; gd.N = DM; gd.K = DM; gd.ldc = DM; gd.mode = 0; break;
        case 9: if (EN(3)) ln_phase2((const bf16_t*)(ws + OFF_MIX8), nullptr, (const bf16_t*)(ws + OFF_X1B), p.ln2_g, p.ln2_b, (bf16_t*)(ws + OFF_B1), nullptr); if (EN(5)) ffn_weights(p, smem); break;
        case 10: gd.A = (const bf16_t*)(ws + OFF_B1); gd.Bt = (const bf16_t*)(ws + OFF_WF1); gd.C = ws + OFF_G; gd.R = p.conv_w; gd.rope = p.conv_b; gd.aux = (float*)(ws + OFF_U);
            gd.M = T_TOK; gd.N = 11008; gd.K = DM; gd.ldc = DFF; gd.mode = 3; break;
        case 11: if (EN(6)) conv_fixup(p); break;
        case 12: gd.A = (const bf16_t*)(ws + OFF_G); gd.Bt = (const bf16_t*)(ws + OFF_WF2); gd.C = ws + OFF_MIX12; gd.M = T_TOK; gd.N = DM; gd.K = DFF; gd.ldc = DM; gd.mode = 0; break;
        case 13: if (EN(3)) ln_phase2((const bf16_t*)(ws + OFF_MIX12), nullptr, (const bf16_t*)(ws + OFF_B1), p.ln3_g, p.ln3_b, nullptr, p.out); break;
        default: break;
        }
        if (EN(7)) if (gd.M) gemm_phase(lds, gd);
        if (ph == 10 && rep == 0 && bid >= 192) wt_run(p, 1, 1376 + (bid - 192), 64, 1376 + 688, smem);
        if (ph == 2 && !(rep == 1 && REP_MODE == 1)) {
            unsigned* ctr = (unsigned*)(ws + OFF_CTR) + rep;
            for (;;) {
                if (threadIdx.x == 0) *(LAS int*)(lds + LDS_SLOT) = (int)atomicAdd(ctr, 1u);
                __syncthreads();
                const int item = *(LAS int*)(lds + LDS_SLOT);
                __syncthreads();
                if (item >= 3072) break;
                if (EN(8)) dilated_item(p, item, lds);
            }
            if (rep == 0) for (;;) {
                if (threadIdx.x == 0) *(LAS int*)(lds + LDS_SLOT) = (int)atomicAdd(ctr + 4, 1u);
                __syncthreads();
                const int j = *(LAS int*)(lds + LDS_SLOT);
                __syncthreads();
                if (j >= 768) break;
                wt_one(p, 0, j < 512 ? 768 + j : 1792 + (j - 512), smem);
            }
        }
      }
        if (ph + 1 < p.ph_hi) { for (int r = 0; r < REP_SYNC; ++r) xcd_barrier(xb); }
    }
}

extern "C" void kernel_launch(void* const* d_in, const int* in_sizes, int n_in, void* d_out, int out_size, void* d_ws, size_t ws_size, hipStream_t stream) {
    static int grid_blocks = 0;
    if (grid_blocks == 0) {
        if (ws_size < WS_NEED) { fprintf(stderr, "kernel_launch: workspace too small: %zu < %zu\n", ws_size, (size_t)WS_NEED); grid_blocks = -1; return; }
        int dev = 0, cus = 0, per_cu = 0;
        hipGetDevice(&dev);
        hipDeviceGetAttribute(&cus, hipDeviceAttributeMultiprocessorCount, dev);
        if (hipFuncSetAttribute((const void*)fwd_megakernel, hipFuncAttributeMaxDynamicSharedMemorySize, LDS_BYTES) != hipSuccess) { fprintf(stderr, "kernel_launch: hipFuncSetAttribute failed\n"); grid_blocks = -1; return; }
        hipOccupancyMaxActiveBlocksPerMultiprocessor(&per_cu, (const void*)fwd_megakernel, 512, LDS_BYTES);
        if (per_cu < 1) { fprintf(stderr, "kernel_launch: occupancy query says %d blocks per CU\n", per_cu); per_cu = 1; }
        if (per_cu > 1) per_cu = 1;
        grid_blocks = cus * per_cu;
        fprintf(stderr, "kernel_launch: grid %d (cus %d), ws %zu\n", grid_blocks, cus, ws_size);
    }
    if (grid_blocks < 0) return;
    Params p{};
    p.x = (const float*)d_in[0]; p.mem = (const float*)d_in[1]; p.pos = (const int*)d_in[2]; p.w_in = (const float*)d_in[3]; p.gate_w2 = (const float*)d_in[4]; p.gate_b = (const float*)d_in[5];
    p.norm_g = (const float*)d_in[6]; p.w_out = (const float*)d_in[7]; p.ln1_g = (const float*)d_in[8]; p.ln1_b = (const float*)d_in[9]; p.ca_wq = (const float*)d_in[10]; p.ca_wkv = (const float*)d_in[11];
    p.ca_wo = (const float*)d_in[12]; p.ln2_g = (const float*)d_in[13]; p.ln2_b = (const float*)d_in[14]; p.ffn_w_in = (const float*)d_in[15]; p.conv_w = (const float*)d_in[16]; p.conv_b = (const float*)d_in[17];
    p.ffn_w_out = (const float*)d_in[18]; p.ln3_g = (const float*)d_in[19]; p.ln3_b = (const float*)d_in[20];
    p.out = (float*)d_out; p.ws = (unsigned char*)d_ws;
#if ONE_LAUNCH
    if (hipMemsetAsync((unsigned char*)d_ws + OFF_BAR, 0, XCD_BAR_WORDS * 4, stream) != hipSuccess) { fprintf(stderr, "kernel_launch: memset of barrier words failed\n"); return; }
    p.ph_lo = 0; p.ph_hi = NPHASE;
    void* args[] = {&p};
    hipError_t e = hipLaunchCooperativeKernel((void*)fwd_megakernel, dim3(grid_blocks), dim3(512), args, LDS_BYTES, stream);
    if (e != hipSuccess) fprintf(stderr, "cooperative launch failed: %s (grid %d)\n", hipGetErrorString(e), grid_blocks);
#else
    for (int ph = 0; ph < NPHASE; ++ph) {
        p.ph_lo = ph; p.ph_hi = ph + 1;
        hipLaunchKernelGGL(fwd_megakernel, dim3(grid_blocks), dim3(512), LDS_BYTES, stream, p);
    }
#endif
}
```

```cpp
#include <hip/hip_runtime.h>
#include <hip/hip_cooperative_groups.h>
#include <cstdio>
namespace cg = cooperative_groups;

#ifndef ONE_LAUNCH
#define ONE_LAUNCH 1
#endif

#define LAS __attribute__((address_space(3)))
typedef unsigned short bf16_t;
typedef short bf16x8 __attribute__((ext_vector_type(8)));
typedef short s16x4 __attribute__((ext_vector_type(4)));
typedef float f32x4 __attribute__((ext_vector_type(4)));
typedef unsigned u32x4 __attribute__((ext_vector_type(4)));
typedef unsigned u32x2 __attribute__((ext_vector_type(2)));

constexpr int T_TOK = 16384, DM = 2048, SEQ = 4096, HC = 6144, DFF = 5504;
constexpr size_t MiB = 1ull << 20;
constexpr size_t OFF_B1 = 0;
constexpr size_t OFF_B2 = 64 * MiB;
constexpr size_t OFF_WIN = 128 * MiB, OFF_WOUT = 152 * MiB, OFF_WQ = 160 * MiB, OFF_WKV = 168 * MiB, OFF_WO = 184 * MiB;
constexpr size_t OFF_MEMB = 192 * MiB, OFF_MKV = 196 * MiB;
constexpr size_t OFF_LSE = 204 * MiB;
constexpr size_t OFF_CTR = 206 * MiB;
constexpr size_t OFF_ROPE = 206 * MiB + 4096;
constexpr size_t OFF_H = 209 * MiB;
constexpr size_t OFF_OC = 209 * MiB;
constexpr size_t OFF_MIX4 = 209 * MiB, OFF_MIX8 = 273 * MiB, OFF_MIX12 = 129 * MiB;
constexpr size_t OFF_X1B = 401 * MiB;
constexpr size_t OFF_OG = 401 * MiB;
constexpr size_t OFF_OD2 = 433 * MiB;
constexpr size_t OFF_EB = 465 * MiB, OFF_ENB = 481 * MiB;
constexpr size_t OFF_WF1 = 64 * MiB, OFF_WF2 = 107 * MiB;
constexpr size_t OFF_U = 129 * MiB;
constexpr size_t OFF_G = 301 * MiB;
constexpr size_t OFF_BAR = 500 * MiB;
constexpr size_t WS_NEED = 501 * MiB;

constexpr int LDS_BYTES = 143360;
constexpr int LDS_SLOT = 139264;
constexpr int KV_STRIDE = 272, KV_BUF = 256 * 272;

struct Params {
    const float* x; const float* mem; const int* pos; const float* w_in; const float* gate_w2; const float* gate_b; const float* norm_g;
    const float* w_out; const float* ln1_g; const float* ln1_b; const float* ca_wq; const float* ca_wkv; const float* ca_wo; const float* ln2_g; const float* ln2_b;
    const float* ffn_w_in; const float* conv_w; const float* conv_b; const float* ffn_w_out; const float* ln3_g; const float* ln3_b;
    float* out; unsigned char* ws; int ph_lo, ph_hi;
};

__constant__ float c_invf[16] = {1.000000000e+00f, 4.403665960e-01f, 1.939227432e-01f, 8.539710194e-02f, 3.760603070e-02f, 1.656043902e-02f, 7.292664610e-03f, 3.211445874e-03f,
                                 1.414213562e-03f, 6.227723788e-04f, 2.742481884e-04f, 1.207697351e-04f, 5.318296098e-05f, 2.341999971e-05f, 1.031338616e-05f, 4.541670478e-06f};

typedef float f32x2v __attribute__((ext_vector_type(2)));
typedef __bf16 b16x2v __attribute__((ext_vector_type(2)));
__device__ __forceinline__ unsigned cvt_pk_bf16(float lo, float hi) { const f32x2v v = {lo, hi}; const b16x2v r = __builtin_convertvector(v, b16x2v); return __builtin_bit_cast(unsigned, r); }
__device__ __forceinline__ float bflo(unsigned u) { return __uint_as_float(u << 16); }
__device__ __forceinline__ float bfhi(unsigned u) { return __uint_as_float(u & 0xffff0000u); }
__device__ __forceinline__ float fexp2(float x) { return __builtin_amdgcn_exp2f(x); }
__device__ __forceinline__ float flog2(float x) { return __builtin_amdgcn_logf(x); }
constexpr float LOG2E = 1.4426950408889634f, LN2 = 0.6931471805599453f;
__device__ __forceinline__ float silu_f(float v) { return v / (1.0f + fexp2(-v * LOG2E)); }

__device__ __forceinline__ int opaque_tid() { int t = (int)threadIdx.x; asm volatile("" : "+v"(t)); return t; }
__device__ __forceinline__ f32x4 mfma16(bf16x8 a, bf16x8 b, f32x4 c) { return __builtin_amdgcn_mfma_f32_16x16x32_bf16(a, b, c, 0, 0, 0); }

__device__ __forceinline__ bf16x8 frag_row(const LAS unsigned char* base, int stride, int row0, int k0, int idx, int g) {
    return *(const LAS bf16x8*)(base + (row0 + idx) * stride + (k0 + 8 * g) * 2);
}
__device__ __forceinline__ bf16x8 frag_tr(unsigned base_addr, int stride, int k0, int col0, int idx, int g) {
    const unsigned a0 = base_addr + (unsigned)((k0 + 8 * g + (idx >> 2)) * stride + (col0 + 4 * (idx & 3)) * 2);
    const unsigned a1 = a0 + 4u * (unsigned)stride;
    s16x4 r0, r1;
    asm volatile("ds_read_b64_tr_b16 %0, %2\n\tds_read_b64_tr_b16 %1, %3\n\ts_waitcnt lgkmcnt(0)" : "=&v"(r0), "=&v"(r1) : "v"(a0), "v"(a1) : "memory");
    bf16x8 f; f[0] = r0[0]; f[1] = r0[1]; f[2] = r0[2]; f[3] = r0[3]; f[4] = r1[0]; f[5] = r1[1]; f[6] = r1[2]; f[7] = r1[3]; return f;
}
__device__ __forceinline__ void tr_frag4(unsigned a, unsigned b, bf16x8 (&f)[4]) {
    s16x4 x0, x1, x2, x3, y0, y1, y2, y3;
    asm volatile("ds_read_b64_tr_b16 %0, %8\n\tds_read_b64_tr_b16 %1, %8 offset:32\n\tds_read_b64_tr_b16 %2, %8 offset:64\n\tds_read_b64_tr_b16 %3, %8 offset:96\n\t"
                 "ds_read_b64_tr_b16 %4, %9\n\tds_read_b64_tr_b16 %5, %9 offset:32\n\tds_read_b64_tr_b16 %6, %9 offset:64\n\tds_read_b64_tr_b16 %7, %9 offset:96\n\t"
                 "s_waitcnt lgkmcnt(0)"
                 : "=&v"(x0), "=&v"(x1), "=&v"(x2), "=&v"(x3), "=&v"(y0), "=&v"(y1), "=&v"(y2), "=&v"(y3) : "v"(a), "v"(b) : "memory");
#define MK(F, X, Y) F[0] = X[0]; F[1] = X[1]; F[2] = X[2]; F[3] = X[3]; F[4] = Y[0]; F[5] = Y[1]; F[6] = Y[2]; F[7] = Y[3];
    MK(f[0], x0, y0) MK(f[1], x1, y1) MK(f[2], x2, y2) MK(f[3], x3, y3)
#undef MK
}

constexpr int BM = 256, BK = 64, HALF = 128, HTB = HALF * BK * 2, NXCD = 8, WGM = 8;
__device__ __forceinline__ int lds_byte(int r, int c) { const int st = (r >> 4) * 2 + (c >> 5), rr = r & 15, cc = c & 31, ob = rr * 64 + cc * 2; return st * 1024 + (ob ^ (((ob >> 9) & 1) << 5)); }
__device__ __forceinline__ void stage_rc(int b, int& R, int& C) { const int st = b / 1024, sb = b % 1024, swz = sb ^ (((sb >> 9) & 1) << 5); R = (st >> 1) * 16 + swz / 64; C = (st & 1) * 32 + (swz % 64) / 2; }
__device__ __forceinline__ int perm32(int rho) { const int n = rho >> 4, i = rho & 15; return 8 * (i >> 2) + 4 * n + (i & 3); }

struct GemmDesc {
    const bf16_t* A; const bf16_t* Bt; void* C; const float* R; const float* rope; float* aux;
    int M, N, K, ldc, mode, G, c, rbf, order, pad2;
};
struct Unit { int pm, pn; };
__device__ __forceinline__ bool unit_next(const GemmDesc& d, int i, Unit& u) {
    if (d.order == 1) {
        if (i >= 2) return false;
        const int xcd = d.c & 7, j = d.c >> 3; u.pm = 8 * xcd + (j >> 2); u.pn = 2 * (j & 3) + i; return true;
    }
    const int nM = d.M / BM, nN = d.N / BM, nwg = nM * nN;
    const long L = (long)i * d.G + d.c; if (L >= nwg) return false;
    int wgid = (int)L; { const int q = nwg / NXCD, r = nwg % NXCD, xcd = wgid % NXCD, off = wgid / NXCD; wgid = (xcd < r ? xcd * (q + 1) : r * (q + 1) + (xcd - r) * q) + off; }
    const int nig = WGM * nN, gid = wgid / nig, fm = gid * WGM, gsz = (nM - fm) < WGM ? (nM - fm) : WGM;
    u.pm = fm + ((wgid % nig) % gsz); u.pn = (wgid % nig) / gsz; return true;
}
constexpr float DN_ALPHA = 1.189207115002721f;

__device__ __forceinline__ void gemm_epilogue(const GemmDesc& d, const f32x4 (&acc)[2][2][4][2], const Unit& u, int wr, int wc, int fr, int fq) {
    if (d.mode == 2) {
        const int row0 = u.pm * BM + wr * 64 + fr, col0 = u.pn * BM + wc * 32 + 4 * fq;
        float* C = (float*)d.C; const float* R = d.R;
#pragma unroll
        for (int ai = 0; ai < 2; ++ai)
#pragma unroll
            for (int m = 0; m < 4; ++m) {
                const size_t ro = (size_t)(row0 + ai * HALF + m * 16) * d.ldc + col0;
#pragma unroll
                for (int bj = 0; bj < 2; ++bj)
#pragma unroll
                    for (int n = 0; n < 2; ++n) {
                        f32x4 r;
                        if (d.rbf) { const u32x2 rb = *(const u32x2*)((const bf16_t*)d.R + ro + bj * HALF + n * 16); r[0] = bflo(rb.x); r[1] = bfhi(rb.x); r[2] = bflo(rb.y); r[3] = bfhi(rb.y); }
                        else r = *(const f32x4*)(R + ro + bj * HALF + n * 16);
                        *(f32x4*)(C + ro + bj * HALF + n * 16) = r * DN_ALPHA + acc[ai][bj][m][n]; }
            }
    } else {
        const int row0 = u.pm * BM + wr * 64 + fr, col0 = u.pn * BM + wc * 32 + 8 * fq;
        bf16_t* O = (bf16_t*)d.C;
        const bool ropet = (d.mode == 1) && (u.pn >= 12) && (u.pn < 20) && (wc == 0);
        const float qs = (d.mode == 1 && (u.pn < 2 || (u.pn >= 12 && u.pn < 16))) ? 0.08838834764831845f : 1.0f;
        const bool gate = (d.mode == 1) && (u.pn < 4);
        const bf16_t* gtab = (const bf16_t*)d.aux + (u.pn & 1) * 256 + wc * 32 + 8 * fq;
        const bool ginv = (u.pn >= 2);
#pragma unroll
        for (int ai = 0; ai < 2; ++ai)
#pragma unroll
            for (int m = 0; m < 4; ++m) {
                const int row = row0 + ai * HALF + m * 16;
                bf16_t* rowp = O + (size_t)row * d.ldc + col0;
                f32x4 c0 = {1.f, 1.f, 1.f, 1.f}, c1 = c0, s0 = {0.f, 0.f, 0.f, 0.f}, s1 = s0;
                if (ropet) { const float* tp = d.rope + (size_t)row * 32 + 8 * (fq & 1); c0 = *(const f32x4*)tp; c1 = *(const f32x4*)(tp + 4); s0 = *(const f32x4*)(tp + 16); s1 = *(const f32x4*)(tp + 20);
                    if (fq < 2) { s0 = -s0; s1 = -s1; } }
#pragma unroll
                for (int bj = 0; bj < 2; ++bj) {
                    f32x4 v0 = acc[ai][bj][m][0] * qs, v1 = acc[ai][bj][m][1] * qs;
                    if (gate) { const u32x4 e = *(const u32x4*)(gtab + (size_t)row * 512 + bj * HALF);
                        float f[8] = {bflo(e.x), bfhi(e.x), bflo(e.y), bfhi(e.y), bflo(e.z), bfhi(e.z), bflo(e.w), bfhi(e.w)};
                        if (ginv) {
#pragma unroll
                            for (int j = 0; j < 8; ++j) f[j] = __builtin_amdgcn_rcpf(f[j]); }
                        v0[0] *= f[0]; v0[1] *= f[1]; v0[2] *= f[2]; v0[3] *= f[3]; v1[0] *= f[4]; v1[1] *= f[5]; v1[2] *= f[6]; v1[3] *= f[7]; }
                    if (ropet) {
                        f32x4 p0, p1;
#pragma unroll
                        for (int j = 0; j < 4; ++j) { p0[j] = __shfl_xor(v0[j], 32); p1[j] = __shfl_xor(v1[j], 32); }
                        v0 = v0 * c0 + p0 * s0; v1 = v1 * c1 + p1 * s1;
                    }
                    u32x4 w; w.x = cvt_pk_bf16(v0[0], v0[1]); w.y = cvt_pk_bf16(v0[2], v0[3]); w.z = cvt_pk_bf16(v1[0], v1[1]); w.w = cvt_pk_bf16(v1[2], v1[3]);
                    *(u32x4*)(rowp + bj * HALF) = w;
                }
            }
    }
}


__device__ __forceinline__ f32x4 dpp_prev(f32x4 v) {
    f32x4 r;
#pragma unroll
    for (int j = 0; j < 4; ++j) { const float x = v[j]; r[j] = __int_as_float(__builtin_amdgcn_update_dpp(0, __float_as_int(x), 0x111, 0xF, 0xF, true)); }
    return r;
}
__device__ __forceinline__ void conv_epilogue(const GemmDesc& d, const f32x4 (&acc)[2][2][4][2], const Unit& u, int wr, int wc, int fr, int fq, LAS unsigned char* lds) {
    const int L = 16 * wr + fr;
    const bool seq_start = (u.pm & 15) == 0;
    const int ch0 = u.pn * 128 + wc * 32 + fq * 8;
    if (fr == 0 || fr == 15) {
        const int rbase = (fr == 0) ? 4 * wr : 4 * wr + 2;
#pragma unroll
        for (int e2 = 0; e2 < 2; ++e2)
#pragma unroll
            for (int bj = 0; bj < 2; ++bj)
#pragma unroll
                for (int n = 0; n < 2; ++n) {
                    const f32x4 v = (fr == 0) ? acc[0][bj][e2][n] : acc[1][bj][2 + e2][n];
                    *(f32x4*)(d.aux + ((size_t)((u.pm * 8 + rbase + e2) * 2 + bj)) * DFF + ch0 + 4 * n) = v;
                }
    }
    bf16_t* gout = (bf16_t*)d.C;
#pragma unroll
    for (int n = 0; n < 2; ++n) {
        const int ch = ch0 + 4 * n;
        const f32x4 wg0 = *(const f32x4*)(d.R + ch), wg1 = *(const f32x4*)(d.R + 11008 + ch), wg2 = *(const f32x4*)(d.R + 22016 + ch);
        const f32x4 wu0 = *(const f32x4*)(d.R + DFF + ch), wu1 = *(const f32x4*)(d.R + 11008 + DFF + ch), wu2 = *(const f32x4*)(d.R + 22016 + DFF + ch);
        const f32x4 bg = *(const f32x4*)(d.rope + ch), bu = *(const f32x4*)(d.rope + DFF + ch);
        f32x4 pg2 = dpp_prev(acc[1][0][2][n]), pg1 = dpp_prev(acc[1][0][3][n]), pu2 = dpp_prev(acc[1][1][2][n]), pu1 = dpp_prev(acc[1][1][3][n]);
        if (fr == 0) { pg2 = (f32x4){0.f, 0.f, 0.f, 0.f}; pg1 = pg2; pu2 = pg2; pu1 = pg2; }
#pragma unroll
        for (int e = 0; e < 8; ++e) {
            const f32x4 cg_ = acc[e >> 2][0][e & 3][n], cu_ = acc[e >> 2][1][e & 3][n];
            const f32x4 yg = bg + wg0 * pg2 + wg1 * pg1 + wg2 * cg_;
            const f32x4 yu = bu + wu0 * pu2 + wu1 * pu1 + wu2 * cu_;
            f32x4 r;
#pragma unroll
            for (int j = 0; j < 4; ++j) r[j] = silu_f(yg[j]) * yu[j];
            u32x2 pk; pk.x = cvt_pk_bf16(r[0], r[1]); pk.y = cvt_pk_bf16(r[2], r[3]);
            { const bool skip = (fr == 0) && (e < 2) && !(wr == 0 && seq_start);
              if (!skip) *(u32x2*)(gout + (size_t)(u.pm * 256 + 8 * L + e) * DFF + ch) = pk; }
            pg2 = pg1; pg1 = cg_; pu2 = pu1; pu1 = cu_;
        }
    }
}

__device__ __forceinline__ void gemm_phase(LAS unsigned char* lds, const GemmDesc& g) {
    const int tid = opaque_tid(), wid = __builtin_amdgcn_readfirstlane(tid >> 6), lane = tid & 63, wr = wid >> 2, wc = wid & 3, fr = lane & 15, fq = lane >> 4;
    const int K = g.K, nt = K / BK;
    const bool perm = (g.mode != 2);
    unsigned voffA[2], voffB[2];
#pragma unroll
    for (int i = 0; i < 2; ++i) { int R, C; stage_rc(tid * 16 + i * 8192, R, C); const int Rb = perm ? ((R & ~31) + perm32(R & 31)) : R;
        const int Ra = (g.mode == 3) ? (8 * (16 * (R >> 6) + (R & 15)) + ((R >> 4) & 3)) : R;
        voffA[i] = (unsigned)(Ra * K + C) * 2u; voffB[i] = (unsigned)(Rb * K + C) * 2u; }
    const size_t kstep = (size_t)(BK * 2);
    const size_t hstep = (size_t)HALF * K * 2;
    const size_t tstep = 2 * hstep;
    const size_t hstepA = (g.mode == 3) ? (size_t)4 * K * 2 : hstep;
    const unsigned ldsw = (unsigned)wid * 1024u;
    const int aoff = lds_byte(wr * 64 + fr, fq * 8), boff = lds_byte(wc * 32 + fr, fq * 8);
#define PG8_SA(b, h) (((b) * 2 + (h)) * HTB)
#define PG8_SB(b, h) ((4 + (b) * 2 + (h)) * HTB)
#define PG8_STAGE(bufoff, gbase, voff) do { _Pragma("unroll") for (int _i = 0; _i < 2; ++_i) \
        __builtin_amdgcn_global_load_lds((const unsigned*)((const char*)(gbase) + (voff)[_i]), (LAS unsigned*)(lds + (bufoff) + ldsw + _i * 8192), 16, 0, 0); } while (0)
#define PG8_LDA(dst, b, h) do { _Pragma("unroll") for (int m = 0; m < 4; ++m) _Pragma("unroll") for (int k = 0; k < 2; ++k) dst[m][k] = *(const LAS bf16x8*)(lds + PG8_SA(b, h) + aoff + m * 2048 + k * 1024); } while (0)
#define PG8_LDB(dst, b, h) do { _Pragma("unroll") for (int n = 0; n < 2; ++n) _Pragma("unroll") for (int k = 0; k < 2; ++k) dst[n][k] = *(const LAS bf16x8*)(lds + PG8_SB(b, h) + boff + n * 2048 + k * 1024); } while (0)
#define PG8_MMA(ai, bj, At, Bt) do { __builtin_amdgcn_s_setprio(1); _Pragma("unroll") for (int m = 0; m < 4; ++m) _Pragma("unroll") for (int n = 0; n < 2; ++n) _Pragma("unroll") for (int k = 0; k < 2; ++k) \
        acc[ai][bj][m][n] = __builtin_amdgcn_mfma_f32_16x16x32_bf16(Bt[n][k], At[m][k], acc[ai][bj][m][n], 0, 0, 0); __builtin_amdgcn_s_setprio(0); } while (0)
#define PG8_WAIT_V(n) asm volatile("s_waitcnt vmcnt(" #n ")" ::: "memory")
#define PG8_WAIT_L(n) asm volatile("s_waitcnt lgkmcnt(" #n ")" ::: "memory")
#define PG8_BAR __builtin_amdgcn_s_barrier()
#define PG8_SCHED __builtin_amdgcn_sched_barrier(0)
    Unit cur, nxt; int ui = 0;
    if (!unit_next(g, 0, cur)) return;
    f32x4 acc[2][2][4][2];
#pragma unroll
    for (int a = 0; a < 2; ++a)
#pragma unroll
        for (int b = 0; b < 2; ++b)
#pragma unroll
            for (int m = 0; m < 4; ++m)
#pragma unroll
                for (int n = 0; n < 2; ++n) acc[a][b][m][n] = (f32x4){0.f, 0.f, 0.f, 0.f};
    bf16x8 At[4][2], B0[2][2], B1[2][2];
    const char* cA = (const char*)g.A + (size_t)cur.pm * tstep; const char* cB = (const char*)g.Bt + (size_t)cur.pn * tstep;
    PG8_STAGE(PG8_SB(0, 0), cB, voffB); PG8_STAGE(PG8_SA(0, 0), cA, voffA); PG8_STAGE(PG8_SB(0, 1), cB + hstep, voffB); PG8_STAGE(PG8_SA(0, 1), cA + hstepA, voffA);
    if (wr == 1) PG8_BAR;
    PG8_WAIT_V(4); PG8_BAR;
    PG8_STAGE(PG8_SB(1, 0), cB + kstep, voffB); PG8_STAGE(PG8_SA(1, 0), cA + kstep, voffA); PG8_STAGE(PG8_SB(1, 1), cB + hstep + kstep, voffB);
    PG8_WAIT_V(6); PG8_BAR;
    for (;;) {
        const bool has_next = unit_next(g, ui + 1, nxt);
        const char* nA = has_next ? (const char*)g.A + (size_t)nxt.pm * tstep : cA; const char* nB = has_next ? (const char*)g.Bt + (size_t)nxt.pn * tstep : cB;
        for (int t = 0; t < nt; t += 2) {
            const bool last = (t == nt - 2);
            const char* a1 = cA + (size_t)(t + 1) * kstep;
            const char* a2 = last ? nA : cA + (size_t)(t + 2) * kstep; const char* b2 = last ? nB : cB + (size_t)(t + 2) * kstep;
            const char* a3 = a2 + kstep; const char* b3 = b2 + kstep;
            PG8_LDB(B0, 0, 0); PG8_SCHED; PG8_LDA(At, 0, 0); PG8_STAGE(PG8_SA(1, 1), a1 + hstepA, voffA);
            PG8_WAIT_L(8); PG8_BAR; PG8_WAIT_L(0); PG8_MMA(0, 0, At, B0); PG8_BAR; PG8_SCHED;
            PG8_LDB(B1, 0, 1); PG8_STAGE(PG8_SB(0, 0), b2, voffB);
            PG8_BAR; PG8_WAIT_L(0); PG8_MMA(0, 1, At, B1); PG8_BAR;
            PG8_LDA(At, 0, 1); PG8_STAGE(PG8_SA(0, 0), a2, voffA);
            PG8_BAR; PG8_WAIT_L(0); PG8_MMA(1, 0, At, B0); PG8_BAR; PG8_SCHED;
            PG8_STAGE(PG8_SB(0, 1), b2 + hstep, voffB);
            PG8_WAIT_V(6); PG8_BAR; PG8_MMA(1, 1, At, B1); PG8_BAR;
            PG8_LDB(B0, 1, 0); PG8_SCHED; PG8_LDA(At, 1, 0); PG8_STAGE(PG8_SA(0, 1), a2 + hstepA, voffA);
            PG8_WAIT_L(8); PG8_BAR; PG8_WAIT_L(0); PG8_MMA(0, 0, At, B0); PG8_BAR; PG8_SCHED;
            PG8_LDB(B1, 1, 1); PG8_STAGE(PG8_SB(1, 0), b3, voffB);
            PG8_BAR; PG8_WAIT_L(0); PG8_MMA(0, 1, At, B1); PG8_BAR;
            PG8_LDA(At, 1, 1); PG8_STAGE(PG8_SA(1, 0), a3, voffA);
            PG8_BAR; PG8_WAIT_L(0); PG8_MMA(1, 0, At, B0); PG8_BAR; PG8_SCHED;
            PG8_STAGE(PG8_SB(1, 1), b3 + hstep, voffB);
            PG8_WAIT_V(6); PG8_BAR; PG8_MMA(1, 1, At, B1); PG8_BAR;
        }
        if (g.mode == 3) conv_epilogue(g, acc, cur, wr, wc, fr, fq, lds); else gemm_epilogue(g, acc, cur, wr, wc, fr, fq);
        if (!has_next) break;
#pragma unroll
        for (int a = 0; a < 2; ++a)
#pragma unroll
            for (int b = 0; b < 2; ++b)
#pragma unroll
                for (int m = 0; m < 4; ++m)
#pragma unroll
                    for (int n = 0; n < 2; ++n) acc[a][b][m][n] = (f32x4){0.f, 0.f, 0.f, 0.f};
        cur = nxt; cA = nA; cB = nB; ++ui;
    }
    PG8_WAIT_V(0);
    if (wr == 0) PG8_BAR;
    PG8_BAR;
#undef PG8_SA
#undef PG8_SB
#undef PG8_STAGE
#undef PG8_LDA
#undef PG8_LDB
#undef PG8_MMA
#undef PG8_WAIT_V
#undef PG8_WAIT_L
#undef PG8_BAR
#undef PG8_SCHED
}

__device__ __forceinline__ void wt_tile(const float* __restrict__ W, int ldw, int k0, int n0src, bf16_t* __restrict__ Bt, int K, int n0dst, float* tile) {
    const int tid = opaque_tid();
    { const int r = tid >> 4, c4 = tid & 15;
#pragma unroll
      for (int i = 0; i < 2; ++i) { const f32x4 v = *(const f32x4*)(W + (size_t)(k0 + r + 32 * i) * ldw + n0src + 4 * c4); float* tp = tile + (r + 32 * i) * 65 + 4 * c4; tp[0] = v[0]; tp[1] = v[1]; tp[2] = v[2]; tp[3] = v[3]; } }
    __syncthreads();
    { const int n = tid >> 3, kg = tid & 7; float v[8];
#pragma unroll
      for (int e = 0; e < 8; ++e) v[e] = tile[(8 * kg + e) * 65 + n];
      u32x4 w; w.x = cvt_pk_bf16(v[0], v[1]); w.y = cvt_pk_bf16(v[2], v[3]); w.z = cvt_pk_bf16(v[4], v[5]); w.w = cvt_pk_bf16(v[6], v[7]);
      *(u32x4*)(Bt + (size_t)(n0dst + n) * K + k0 + 8 * kg) = w; }
    __syncthreads();
}


struct WtDesc { const float* W; bf16_t* Bt; int ldw, k0, ns0, ns1, K, n0dst; };
__device__ __forceinline__ WtDesc wt_decode(const Params& p, int grp, int tl) {
    WtDesc d; unsigned char* ws = p.ws;
    if (grp == 0) {
        if (tl < 768)       { const int kt = tl & 31, nt = tl >> 5; const int n0 = nt * 256, s0 = n0 + (n0 >= 3072 ? 16 : 0); d.W = p.w_in; d.ldw = 6160; d.k0 = kt * 64; d.ns0 = s0; d.ns1 = s0 + 128; d.Bt = (bf16_t*)(ws + OFF_WIN); d.K = 2048; d.n0dst = n0; }
        else if (tl < 1024) { const int q = tl - 768;  d.W = p.w_out;  d.ldw = 2048; d.k0 = (q & 31) * 64; d.ns0 = (q >> 5) * 256; d.ns1 = d.ns0 + 128; d.Bt = (bf16_t*)(ws + OFF_WOUT); d.K = 2048; d.n0dst = d.ns0; }
        else if (tl < 1280) { const int q = tl - 1024; d.W = p.ca_wq;  d.ldw = 2048; d.k0 = (q & 31) * 64; d.ns0 = (q >> 5) * 256; d.ns1 = d.ns0 + 128; d.Bt = (bf16_t*)(ws + OFF_WQ);   d.K = 2048; d.n0dst = d.ns0; }
        else if (tl < 1792) { const int q = tl - 1280; d.W = p.ca_wkv; d.ldw = 4096; d.k0 = (q & 31) * 64; d.ns0 = (q >> 5) * 256; d.ns1 = d.ns0 + 128; d.Bt = (bf16_t*)(ws + OFF_WKV);  d.K = 2048; d.n0dst = d.ns0; }
        else                { const int q = tl - 1792; d.W = p.ca_wo;  d.ldw = 2048; d.k0 = (q & 31) * 64; d.ns0 = (q >> 5) * 256; d.ns1 = d.ns0 + 128; d.Bt = (bf16_t*)(ws + OFF_WO);   d.K = 2048; d.n0dst = d.ns0; }
    } else {
        if (tl < 1376) { const int kt = tl & 31, pn = tl >> 5; d.W = p.ffn_w_in; d.ldw = 11008; d.k0 = kt * 64; d.ns0 = pn * 128; d.ns1 = DFF + pn * 128; d.Bt = (bf16_t*)(ws + OFF_WF1); d.K = 2048; d.n0dst = pn * 256; }
        else { const int q = tl - 1376; const int kt = q % 86, nt = q / 86; d.W = p.ffn_w_out; d.ldw = 2048; d.k0 = kt * 64; d.ns0 = nt * 256; d.ns1 = d.ns0 + 128; d.Bt = (bf16_t*)(ws + OFF_WF2); d.K = DFF; d.n0dst = nt * 256; }
    }
    return d;
}
__device__ __forceinline__ void wt_load(const WtDesc& d, int tid, f32x4 (&v)[8]) {
    const int r = tid >> 6, c4 = tid & 63; const int col = (c4 < 32) ? d.ns0 + 4 * c4 : d.ns1 + 4 * (c4 - 32);
#pragma unroll
    for (int i = 0; i < 8; ++i) v[i] = *(const f32x4*)(d.W + (size_t)(d.k0 + r + 8 * i) * d.ldw + col);
}
__device__ __forceinline__ int wt_remap(int grp, int t) { return (grp == 2) ? (t < 768 ? t : t + 512) : t; }
__device__ void wt_run(const Params& p, int grp, int first, int stride, int ntiles, unsigned char* smem_g) {
    constexpr int LD = 260;
    float* tile = (float*)smem_g;
    const int tid = opaque_tid();
    int tl = first;
    if (tl >= ntiles) return;
    const int dg = (grp == 2) ? 0 : grp;
    WtDesc cur = wt_decode(p, dg, wt_remap(grp, tl)); f32x4 v[8];
    wt_load(cur, tid, v);
    for (;;) {
        { const int r = tid >> 6, c4 = tid & 63;
#pragma unroll
          for (int i = 0; i < 8; ++i) *(f32x4*)(tile + (r + 8 * i) * LD + 4 * c4) = v[i]; }
        const int nxt = tl + stride; const bool has = nxt < ntiles;
        WtDesc nd = cur;
        if (has) { nd = wt_decode(p, dg, wt_remap(grp, nxt)); wt_load(nd, tid, v); }
        __syncthreads();
        { const int n = tid >> 1, kh = tid & 1;
#pragma unroll
          for (int q = 0; q < 4; ++q) {
              float e[8];
#pragma unroll
              for (int j = 0; j < 8; ++j) e[j] = tile[(32 * kh + 8 * q + j) * LD + n];
              u32x4 w; w.x = cvt_pk_bf16(e[0], e[1]); w.y = cvt_pk_bf16(e[2], e[3]); w.z = cvt_pk_bf16(e[4], e[5]); w.w = cvt_pk_bf16(e[6], e[7]);
              *(u32x4*)(cur.Bt + (size_t)(cur.n0dst + n) * cur.K + cur.k0 + 32 * kh + 8 * q) = w;
          } }
        __syncthreads();
        if (!has) break;
        tl = nxt; cur = nd;
    }
}


__device__ void wt_one(const Params& p, int grp, int tl, unsigned char* smem_g) {
    constexpr int LD = 260;
    float* tile = (float*)smem_g;
    const int tid = opaque_tid();
    const WtDesc cur = wt_decode(p, grp, tl); f32x4 v[8];
    wt_load(cur, tid, v);
    { const int r = tid >> 6, c4 = tid & 63;
#pragma unroll
      for (int i = 0; i < 8; ++i) *(f32x4*)(tile + (r + 8 * i) * LD + 4 * c4) = v[i]; }
    __syncthreads();
    { const int n = tid >> 1, kh = tid & 1;
#pragma unroll
      for (int q = 0; q < 4; ++q) {
          float e[8];
#pragma unroll
          for (int j = 0; j < 8; ++j) e[j] = tile[(32 * kh + 8 * q + j) * LD + n];
          u32x4 w; w.x = cvt_pk_bf16(e[0], e[1]); w.y = cvt_pk_bf16(e[2], e[3]); w.z = cvt_pk_bf16(e[4], e[5]); w.w = cvt_pk_bf16(e[6], e[7]);
          *(u32x4*)(cur.Bt + (size_t)(cur.n0dst + n) * cur.K + cur.k0 + 32 * kh + 8 * q) = w;
      } }
    __syncthreads();
}

__device__ void prep_phase(const Params& p, unsigned char* smem_g) {
    const int tid = opaque_tid(), lane = tid & 63, wid = tid >> 6, idx = lane & 15, g = lane >> 4;
    unsigned char* ws = p.ws;
    float* red = (float*)smem_g;
    float* glrs = (float*)(smem_g + 32768);
    if (blockIdx.x == 0 && tid < 64) ((unsigned*)(ws + OFF_CTR))[tid] = 0u;
    bf16_t* xb = (bf16_t*)(ws + OFF_B1);
    bf16_t* ebp = (bf16_t*)(ws + OFF_EB); bf16_t* enbp = (bf16_t*)(ws + OFF_ENB);
    for (int ch = blockIdx.x; ch < T_TOK / 64; ch += gridDim.x) {
        const int t0 = ch * 64;
        const int wk = (wid + (int)blockIdx.x) & 7, mrot = ((int)blockIdx.x >> 3) & 3;
        bf16x8 bfr[8];
#pragma unroll
        for (int ks = 0; ks < 8; ++ks) {
            float v[8];
#pragma unroll
            for (int e = 0; e < 8; ++e) v[e] = p.w_in[(size_t)(256 * wk + 32 * ks + 8 * g + e) * 6160 + 3072 + idx];
            u32x4 w; w.x = cvt_pk_bf16(v[0], v[1]); w.y = cvt_pk_bf16(v[2], v[3]); w.z = cvt_pk_bf16(v[4], v[5]); w.w = cvt_pk_bf16(v[6], v[7]);
            bfr[ks] = __builtin_bit_cast(bf16x8, w);
        }
        f32x4 acc[4];
#pragma unroll
        for (int mt = 0; mt < 4; ++mt) {
            acc[mt] = (f32x4){0.f, 0.f, 0.f, 0.f};
#pragma unroll
            for (int ks = 0; ks < 8; ++ks) {
                const size_t off = (size_t)(t0 + 16 * ((mt + mrot) & 3) + idx) * DM + 256 * wk + 32 * ks + 8 * g;
                const f32x4 a = *(const f32x4*)(p.x + off), b = *(const f32x4*)(p.x + off + 4);
                u32x4 w; w.x = cvt_pk_bf16(a[0], a[1]); w.y = cvt_pk_bf16(a[2], a[3]); w.z = cvt_pk_bf16(b[0], b[1]); w.w = cvt_pk_bf16(b[2], b[3]);
                *(u32x4*)(xb + off) = w;
                acc[mt] = mfma16(__builtin_bit_cast(bf16x8, w), bfr[ks], acc[mt]);
            }
        }
#pragma unroll
        for (int mt = 0; mt < 4; ++mt)
#pragma unroll
            for (int r = 0; r < 4; ++r) red[(wid * 64 + 16 * ((mt + mrot) & 3) + 4 * g + r) * 16 + idx] = acc[mt][r];
        __syncthreads();
        { const int tok = tid >> 3, c2 = (tid & 7) * 2; float s0 = 0.f, s1 = 0.f;
#pragma unroll
          for (int w = 0; w < 8; ++w) { s0 += red[(w * 64 + tok) * 16 + c2]; s1 += red[(w * 64 + tok) * 16 + c2 + 1]; }
          glrs[tok * 16 + c2] = s0; glrs[tok * 16 + c2 + 1] = s1; }
        __syncthreads();
        { const int c = tid; float w2c[16];
#pragma unroll
          for (int r = 0; r < 16; ++r) w2c[r] = p.gate_w2[r * 512 + c];
          const float bias = p.gate_b[c]; float b2 = 0.f;
          for (int t = 0; t < 64; ++t) {
              float z = bias;
#pragma unroll
              for (int r4 = 0; r4 < 4; ++r4) { const f32x4 gv = *(const f32x4*)(glrs + t * 16 + 4 * r4); z += gv[0] * w2c[4 * r4] + gv[1] * w2c[4 * r4 + 1] + gv[2] * w2c[4 * r4 + 2] + gv[3] * w2c[4 * r4 + 3]; }
              const float az = fabsf(z);
              const float ls2 = fminf(z, 0.f) * LOG2E - flog2(1.0f + fexp2(-az * LOG2E));
              b2 += ls2 * 0.0625f;
              const float e = fexp2(b2);
              ebp[(size_t)(t0 + t) * 512 + c] = (bf16_t)(cvt_pk_bf16(e, e) & 0xffffu);
          } }
        __syncthreads();
    }
    { float* tab = (float*)(ws + OFF_ROPE);
      for (int e = blockIdx.x * 512 + tid; e < T_TOK * 16; e += gridDim.x * 512) {
          const int tok = e >> 4, i = e & 15;
          const float ang = (float)p.pos[tok] * c_invf[i];
          const double rev = (double)ang * 0.15915494309189535; const float fr = (float)(rev - rint(rev));
          tab[tok * 32 + i] = __builtin_amdgcn_cosf(fr); tab[tok * 32 + 16 + i] = __builtin_amdgcn_sinf(fr);
      } }
    { bf16_t* mb = (bf16_t*)(ws + OFF_MEMB);
      for (int e = blockIdx.x * 512 + tid; e < 1024 * 2048 / 4; e += gridDim.x * 512) { const f32x4 v = *(const f32x4*)(p.mem + (size_t)e * 4); u32x2 w; w.x = cvt_pk_bf16(v[0], v[1]); w.y = cvt_pk_bf16(v[2], v[3]); *(u32x2*)(mb + (size_t)e * 4) = w; } }
    wt_run(p, 2, (int)blockIdx.x, (int)gridDim.x, 1280, smem_g);
}

__device__ void ffn_weights(const Params& p, unsigned char* smem_g) { wt_run(p, 1, (int)blockIdx.x, (int)gridDim.x, 1376, smem_g); }

struct GlaRegs { u32x4 rq[2], rk[2], rv; u32x2 rdec; };
#define GLD(dst, ptr) asm volatile("global_load_dwordx4 %0, %1, off" : "=v"(dst) : "v"(ptr) : "memory")
#define GLD2(dst, ptr) asm volatile("global_load_dwordx2 %0, %1, off" : "=v"(dst) : "v"(ptr) : "memory")
__device__ __forceinline__ void gla_load(GlaRegs& R, int n, int t, const bf16_t* hq, const bf16_t* hv, const bf16_t* pdec) {
    const size_t tk = (size_t)(n * 64 + t);
    const bf16_t* a0 = hq + tk * HC; const bf16_t* a3 = pdec + (size_t)(n * 64 + 63) * 512; const bf16_t* a4 = hv + tk * HC;
    GLD(R.rq[0], a0); GLD(R.rq[1], a0 + 8); GLD(R.rk[0], a0 + 512); GLD(R.rk[1], a0 + 520); GLD(R.rv, a4); GLD2(R.rdec, a3);
}
__device__ __forceinline__ void gla_wait(GlaRegs& R, bool first) {
    if (first) asm volatile("s_waitcnt vmcnt(6)" : "+v"(R.rq[0]), "+v"(R.rq[1]), "+v"(R.rk[0]), "+v"(R.rk[1]), "+v"(R.rv), "+v"(R.rdec) :: "memory");
    else       asm volatile("s_waitcnt vmcnt(10)" : "+v"(R.rq[0]), "+v"(R.rq[1]), "+v"(R.rk[0]), "+v"(R.rk[1]), "+v"(R.rv), "+v"(R.rdec) :: "memory");
}
#define MKF(F, X, Y) F[0] = X[0]; F[1] = X[1]; F[2] = X[2]; F[3] = X[3]; F[4] = Y[0]; F[5] = Y[1]; F[6] = Y[2]; F[7] = Y[3];
#define LDS_BARRIER() do { asm volatile("s_waitcnt lgkmcnt(0)" ::: "memory"); __builtin_amdgcn_s_barrier(); asm volatile("" ::: "memory"); } while (0)
__device__ void gla_item(const Params& p, int item, LAS unsigned char* lds) {
    const int tid = opaque_tid(), lane = tid & 63, w = __builtin_amdgcn_readfirstlane(tid >> 6), idx = lane & 15, g = lane >> 4;
    const int b = item >> 4, hh = (item >> 2) & 3, sl = item & 3;
    constexpr int QS0 = 0, KS = 34816, VS0 = 52224, ST0 = 70656, AS = 105472;
    const unsigned lbase = (unsigned)(size_t)lds;
    unsigned char* ws = p.ws;
    const bf16_t* h = (const bf16_t*)(ws + OFF_H);
    bf16_t* og = (bf16_t*)(ws + OFF_OG);
    const int t = tid >> 3, cgp = tid & 7;
    const bf16_t* hq = h + (size_t)(b * SEQ) * HC + hh * 128 + cgp * 16;
    const bf16_t* hv = h + (size_t)(b * SEQ) * HC + 1024 + hh * 256 + sl * 64 + cgp * 8;
    const bf16_t* pdec = (const bf16_t*)(ws + OFF_EB) + (size_t)(b * SEQ) * 512 + hh * 128 + 16 * w + 4 * g;
    { unsigned zz = 0u; asm volatile("" : "+v"(zz)); const u32x4 zv = {zz, zz, zz, zz};
      for (int i = tid; i < 17408 / 16; i += 512) *(LAS u32x4*)(lds + ST0 + i * 16) = zv; }
    f32x4 S[4];
#pragma unroll
    for (int i = 0; i < 4; ++i) S[i] = (f32x4){0.f, 0.f, 0.f, 0.f};
    const int jt = w >> 1, it0 = 2 * (w & 1);
    GlaRegs RA, RB;
    gla_load(RA, 0, t, hq, hv, pdec); gla_load(RB, 1, t, hq, hv, pdec);
    for (int n2 = 0; n2 < 64; n2 += 2) {
#pragma unroll
      for (int par = 0; par < 2; ++par) {
        const int n = n2 + par;
        GlaRegs& R = par ? RB : RA;
        const int qs = QS0 + par * 17408, vs = VS0 + par * 9216, stc = ST0 + par * 17408, stn = ST0 + (par ^ 1) * 17408;
        gla_wait(R, n2 == 0);
        *(LAS u32x4*)(lds + qs + t * 272 + cgp * 32) = R.rq[0]; *(LAS u32x4*)(lds + qs + t * 272 + cgp * 32 + 16) = R.rq[1];
        *(LAS u32x4*)(lds + KS + t * 272 + cgp * 32) = R.rk[0]; *(LAS u32x4*)(lds + KS + t * 272 + cgp * 32 + 16) = R.rk[1];
        *(LAS u32x4*)(lds + vs + t * 144 + cgp * 16) = R.rv;
        f32x4 dc; dc[0] = bflo(R.rdec.x); dc[1] = bfhi(R.rdec.x); dc[2] = bflo(R.rdec.y); dc[3] = bfhi(R.rdec.y);
        asm volatile("" : "+v"(dc) :: "memory");
        gla_load(R, (n + 2 < 64) ? n + 2 : 63, t, hq, hv, pdec);
        LDS_BARRIER();
        const unsigned kaddr = lbase + KS + (unsigned)((8 * g + (idx >> 2)) * 272 + (16 * w + 4 * (idx & 3)) * 2);
        const unsigned vaddr = lbase + vs + (unsigned)((8 * g + (idx >> 2)) * 144 + (4 * (idx & 3)) * 2);
        s16x4 k00, k01, k10, k11, a0, a1, a2, a3, b0, b1, b2, b3, c0, c1, c2, c3, d0, d1, d2, d3;
        asm volatile(
              "ds_read_b64_tr_b16 %0, %20\n\tds_read_b64_tr_b16 %1, %20 offset:1088\n\tds_read_b64_tr_b16 %2, %20 offset:8704\n\tds_read_b64_tr_b16 %3, %20 offset:9792\n\t"
              "ds_read_b64_tr_b16 %4, %21\n\tds_read_b64_tr_b16 %5, %21 offset:32\n\tds_read_b64_tr_b16 %6, %21 offset:64\n\tds_read_b64_tr_b16 %7, %21 offset:96\n\t"
              "ds_read_b64_tr_b16 %8, %21 offset:576\n\tds_read_b64_tr_b16 %9, %21 offset:608\n\tds_read_b64_tr_b16 %10, %21 offset:640\n\tds_read_b64_tr_b16 %11, %21 offset:672\n\t"
              "ds_read_b64_tr_b16 %12, %21 offset:4608\n\tds_read_b64_tr_b16 %13, %21 offset:4640\n\tds_read_b64_tr_b16 %14, %21 offset:4672\n\tds_read_b64_tr_b16 %15, %21 offset:4704\n\t"
              "ds_read_b64_tr_b16 %16, %21 offset:5184\n\tds_read_b64_tr_b16 %17, %21 offset:5216\n\tds_read_b64_tr_b16 %18, %21 offset:5248\n\tds_read_b64_tr_b16 %19, %21 offset:5280"
              : "=&v"(k00), "=&v"(k01), "=&v"(k10), "=&v"(k11), "=&v"(a0), "=&v"(a1), "=&v"(a2), "=&v"(a3), "=&v"(b0), "=&v"(b1), "=&v"(b2), "=&v"(b3),
                "=&v"(c0), "=&v"(c1), "=&v"(c2), "=&v"(c3), "=&v"(d0), "=&v"(d1), "=&v"(d2), "=&v"(d3)
              : "v"(kaddr), "v"(vaddr) : "memory");
        { bf16x8 kf[4], qa[4], qb[4];
#pragma unroll
          for (int ks = 0; ks < 4; ++ks) { kf[ks] = frag_row(lds + KS, 272, 16 * jt, 32 * ks, idx, g); qa[ks] = frag_row(lds + qs, 272, 16 * it0, 32 * ks, idx, g); qb[ks] = frag_row(lds + qs, 272, 16 * it0 + 16, 32 * ks, idx, g); }
          asm volatile("s_waitcnt lgkmcnt(0)" : "+v"(k00), "+v"(k01), "+v"(k10), "+v"(k11), "+v"(a0), "+v"(a1), "+v"(a2), "+v"(a3), "+v"(b0), "+v"(b1), "+v"(b2), "+v"(b3),
                       "+v"(c0), "+v"(c1), "+v"(c2), "+v"(c3), "+v"(d0), "+v"(d1), "+v"(d2), "+v"(d3) :: "memory");
          f32x4 aa = {0.f, 0.f, 0.f, 0.f}, ab = aa;
#pragma unroll
          for (int ks = 0; ks < 4; ++ks) { aa = mfma16(kf[ks], qa[ks], aa); ab = mfma16(kf[ks], qb[ks], ab); }
          const int j0 = 16 * jt + 4 * g, ia = 16 * it0 + idx, ib = ia + 16;
#pragma unroll
          for (int r = 0; r < 4; ++r) { aa[r] = (j0 + r <= ia) ? aa[r] : 0.f; ab[r] = (j0 + r <= ib) ? ab[r] : 0.f; }
          u32x2 wa, wb; wa.x = cvt_pk_bf16(aa[0], aa[1]); wa.y = cvt_pk_bf16(aa[2], aa[3]); wb.x = cvt_pk_bf16(ab[0], ab[1]); wb.y = cvt_pk_bf16(ab[2], ab[3]);
          *(LAS u32x2*)(lds + AS + ia * 144 + j0 * 2) = wa; *(LAS u32x2*)(lds + AS + ib * 144 + j0 * 2) = wb; }
        {
          bf16x8 ka0, ka1, v0[4], v1[4];
          MKF(ka0, k00, k01) MKF(ka1, k10, k11)
          MKF(v0[0], a0, b0) MKF(v0[1], a1, b1) MKF(v0[2], a2, b2) MKF(v0[3], a3, b3)
          MKF(v1[0], c0, d0) MKF(v1[1], c1, d1) MKF(v1[2], c2, d2) MKF(v1[3], c3, d3)
#pragma unroll
          for (int dvt = 0; dvt < 4; ++dvt) { S[dvt] = mfma16(ka0, v0[dvt], S[dvt]); S[dvt] = mfma16(ka1, v1[dvt], S[dvt]); S[dvt] = S[dvt] * dc; }
#pragma unroll
          for (int dvt = 0; dvt < 4; ++dvt) { u32x2 wv; wv.x = cvt_pk_bf16(S[dvt][0], S[dvt][1]); wv.y = cvt_pk_bf16(S[dvt][2], S[dvt][3]);
              *(LAS u32x2*)(lds + stn + (16 * dvt + idx) * 272 + (16 * w + 4 * g) * 2) = wv; } }
        LDS_BARRIER();
        { const unsigned va = lbase + vs + (unsigned)((8 * g + (idx >> 2)) * 144 + (16 * jt + 4 * (idx & 3)) * 2);
          s16x4 x0, x1, y0, y1;
          asm volatile("ds_read_b64_tr_b16 %0, %4\n\tds_read_b64_tr_b16 %1, %4 offset:576\n\tds_read_b64_tr_b16 %2, %4 offset:4608\n\tds_read_b64_tr_b16 %3, %4 offset:5184"
                       : "=&v"(x0), "=&v"(x1), "=&v"(y0), "=&v"(y1) : "v"(va) : "memory");
          bf16x8 sf[4], qa[4], qb[4], a0f[2], a1f[2];
#pragma unroll
          for (int ks = 0; ks < 4; ++ks) { sf[ks] = frag_row(lds + stc, 272, 16 * jt, 32 * ks, idx, g); qa[ks] = frag_row(lds + qs, 272, 16 * it0, 32 * ks, idx, g); qb[ks] = frag_row(lds + qs, 272, 16 * it0 + 16, 32 * ks, idx, g); }
#pragma unroll
          for (int ks = 0; ks < 2; ++ks) { a0f[ks] = frag_row(lds + AS, 144, 16 * it0, 32 * ks, idx, g); a1f[ks] = frag_row(lds + AS, 144, 16 * it0 + 16, 32 * ks, idx, g); }
          asm volatile("s_waitcnt lgkmcnt(0)" : "+v"(x0), "+v"(x1), "+v"(y0), "+v"(y1) :: "memory");
          bf16x8 vf0, vf1;
          MKF(vf0, x0, x1) MKF(vf1, y0, y1)
          f32x4 oa = {0.f, 0.f, 0.f, 0.f}, ob = oa;
          oa = mfma16(vf0, a0f[0], oa); ob = mfma16(vf0, a1f[0], ob); oa = mfma16(vf1, a0f[1], oa); ob = mfma16(vf1, a1f[1], ob);
#pragma unroll
          for (int ks = 0; ks < 4; ++ks) { oa = mfma16(sf[ks], qa[ks], oa); ob = mfma16(sf[ks], qb[ks], ob); }
          u32x2 wa, wb; wa.x = cvt_pk_bf16(oa[0], oa[1]); wa.y = cvt_pk_bf16(oa[2], oa[3]); wb.x = cvt_pk_bf16(ob[0], ob[1]); wb.y = cvt_pk_bf16(ob[2], ob[3]);
          bf16_t* op = og + (size_t)(b * SEQ + n * 64 + 16 * it0 + idx) * 1024 + hh * 256 + sl * 64 + 16 * jt + 4 * g;
          *(u32x2*)op = wa; *(u32x2*)(op + 16 * 1024) = wb; }
      }
    }
    asm volatile("s_waitcnt vmcnt(0)" ::: "memory");
    __syncthreads();
}
#undef MKF

__device__ __forceinline__ void dil_preload(const Params& p, int item, int tid, u32x4 (&pk)[8], u32x4 (&pv)[8]) {
    const int pat = item >> 10, rem = item & 1023, b = rem >> 8, head = (rem >> 5) & 7, sb = rem & 31;
    const int dsh = pat * 2, nbsh = 5 - dsh;
    const int r = sb >> nbsh, blk = sb & ((1 << nbsh) - 1);
    const bf16_t* hb = (const bf16_t*)(p.ws + OFF_H) + (size_t)(b * SEQ) * HC;
    const int piece = tid & 15;
#pragma unroll
    for (int it = 0; it < 8; ++it) {
        const int row = (tid >> 4) + 32 * it, lj = (blk - 1) * 128 + row;
        u32x4 kv = {0u, 0u, 0u, 0u}, vv = kv;
        if (lj >= 0) { const int pos = r + (lj << dsh); const bf16_t* rp = hb + (size_t)pos * HC + head * 128 + piece * 8; kv = *(const u32x4*)(rp + 4096); vv = *(const u32x4*)(rp + 5120); }
        pk[it] = kv; pv[it] = vv;
    }
}
__device__ __forceinline__ void dilated_item(const Params& p, int item, int next, u32x4 (&pk)[8], u32x4 (&pv)[8], LAS unsigned char* lds) {
    const int tid = opaque_tid(), lane = tid & 63, w = __builtin_amdgcn_readfirstlane(tid >> 6), idx = lane & 15, g = lane >> 4;
    const int pat = item >> 10, rem = item & 1023, b = rem >> 8, head = (rem >> 5) & 7, sb = rem & 31;
    const int dsh = pat * 2, nbsh = 5 - dsh;
    const int r = sb >> nbsh, blk = sb & ((1 << nbsh) - 1);
    unsigned char* ws = p.ws;
    const bf16_t* hb = (const bf16_t*)(ws + OFF_H) + (size_t)(b * SEQ) * HC;
    const unsigned lbase = (unsigned)(size_t)lds;
    { const int piece = tid & 15;
#pragma unroll
      for (int it = 0; it < 8; ++it) { const int row = (tid >> 4) + 32 * it;
          *(LAS u32x4*)(lds + row * KV_STRIDE + piece * 16) = pk[it]; *(LAS u32x4*)(lds + KV_BUF + row * KV_STRIDE + piece * 16) = pv[it]; } }
    const int qpos = r + ((blk * 128 + 16 * w + idx) << dsh);
    bf16x8 qf[4];
    { const bf16_t* qp = hb + (size_t)qpos * HC + 3072 + head * 128 + 8 * g;
#pragma unroll
      for (int ks = 0; ks < 4; ++ks) qf[ks] = *(const bf16x8*)(qp + 32 * ks); }
    if (next < 3072) dil_preload(p, next, tid, pk, pv);
    LDS_BARRIER();
    f32x4 sc[9];
#pragma unroll
    for (int tt = 0; tt < 9; ++tt) {
        sc[tt] = (f32x4){0.f, 0.f, 0.f, 0.f};
#pragma unroll
        for (int ks = 0; ks < 4; ++ks) sc[tt] = mfma16(frag_row(lds, KV_STRIDE, 16 * (w + tt), 32 * ks, idx, g), qf[ks], sc[tt]);
    }
    const int qi = 128 + 16 * w + idx;
    float mx = -1e30f;
#pragma unroll
    for (int tt = 0; tt < 9; ++tt)
#pragma unroll
        for (int rr = 0; rr < 4; ++rr) {
            const int kj = 16 * (w + tt) + 4 * g + rr, diff = qi - kj;
            const bool valid = (diff >= 0) && (diff <= 128) && (blk > 0 || kj >= 128);
            const float s = valid ? sc[tt][rr] * LOG2E : -1e30f;
            sc[tt][rr] = s; mx = fmaxf(mx, s);
        }
    mx = fmaxf(mx, __shfl_xor(mx, 16)); mx = fmaxf(mx, __shfl_xor(mx, 32));
    float sum = 0.f;
#pragma unroll
    for (int tt = 0; tt < 9; ++tt)
#pragma unroll
        for (int rr = 0; rr < 4; ++rr) { const float e = fexp2(sc[tt][rr] - mx); sc[tt][rr] = e; sum += e; }
    sum += __shfl_xor(sum, 16); sum += __shfl_xor(sum, 32);
    f32x4 ot[8];
#pragma unroll
    for (int c = 0; c < 8; ++c) ot[c] = (f32x4){0.f, 0.f, 0.f, 0.f};
#pragma unroll
    for (int s5 = 0; s5 < 5; ++s5) {
        const int ta = w + 2 * s5, tb = (s5 < 4) ? ta + 1 : ta;
        u32x4 pw; pw.x = cvt_pk_bf16(sc[2 * s5][0], sc[2 * s5][1]); pw.y = cvt_pk_bf16(sc[2 * s5][2], sc[2 * s5][3]);
        if (s5 < 4) { pw.z = cvt_pk_bf16(sc[(2 * s5 + 1) % 9][0], sc[(2 * s5 + 1) % 9][1]); pw.w = cvt_pk_bf16(sc[(2 * s5 + 1) % 9][2], sc[(2 * s5 + 1) % 9][3]); } else { pw.z = 0u; pw.w = 0u; }
        const bf16x8 pf = __builtin_bit_cast(bf16x8, pw);
        const unsigned aA = lbase + KV_BUF + (unsigned)((16 * ta + 4 * g + (idx >> 2)) * KV_STRIDE + 8 * (idx & 3));
        const unsigned aB = lbase + KV_BUF + (unsigned)((16 * tb + 4 * g + (idx >> 2)) * KV_STRIDE + 8 * (idx & 3));
        bf16x8 vf[4];
        tr_frag4(aA, aB, vf);
#pragma unroll
        for (int c = 0; c < 4; ++c) ot[c] = mfma16(vf[c], pf, ot[c]);
        tr_frag4(aA + 128, aB + 128, vf);
#pragma unroll
        for (int c = 0; c < 4; ++c) ot[4 + c] = mfma16(vf[c], pf, ot[4 + c]);
    }
    const float inv = 1.0f / sum;
    const size_t tok = (size_t)(b * SEQ + qpos);
    bf16_t* od = (bf16_t*)(ws + (pat == 0 ? OFF_B2 : (pat == 1 ? OFF_B2 + 32 * MiB : OFF_OD2)));
#pragma unroll
    for (int c = 0; c < 8; ++c) { u32x2 wv; wv.x = cvt_pk_bf16(ot[c][0] * inv, ot[c][1] * inv); wv.y = cvt_pk_bf16(ot[c][2] * inv, ot[c][3] * inv);
        *(u32x2*)(od + tok * 1024 + head * 128 + 16 * c + 4 * g) = wv; }
    if (g == 0) ((float*)(ws + OFF_LSE))[(size_t)pat * T_TOK * 8 + tok * 8 + head] = (mx + flog2(sum)) * LN2;
    LDS_BARRIER();
}

__device__ void cross_items(const Params& p, LAS unsigned char* lds) {
    const int tid = opaque_tid(), lane = tid & 63, w = __builtin_amdgcn_readfirstlane(tid >> 6), idx = lane & 15, g = lane >> 4;
    unsigned char* ws = p.ws;
    bf16_t* oc = (bf16_t*)(ws + OFF_OC);
    const unsigned lbase = (unsigned)(size_t)lds;
    const int piece = tid & 15, srow = tid >> 4;
    const int G = (int)gridDim.x;
    u32x4 pre[8];
#define XLOAD(kvbase, c8) do { const bf16_t* _src = (kvbase) + (((c8) >= 4) ? 2048 : 0) + ((c8) & 3) * 128 + piece * 8; \
        _Pragma("unroll") for (int _it = 0; _it < 8; ++_it) pre[_it] = *(const u32x4*)(_src + (size_t)(srow + 32 * _it) * 4096); } while (0)
#define XSTORE(buf) do { _Pragma("unroll") for (int _it = 0; _it < 8; ++_it) *(LAS u32x4*)((buf) + (srow + 32 * _it) * KV_STRIDE + piece * 16) = pre[_it]; } while (0)
    const int pmx = 8 * ((int)blockIdx.x & 7) + ((int)blockIdx.x >> 5), hdx = ((int)blockIdx.x >> 3) & 3;
    const int item0 = (pmx >> 4) * 128 + hdx * 32 + 2 * (pmx & 15);
    { const bf16_t* kvb0 = (const bf16_t*)(ws + OFF_MKV) + (size_t)((item0 >> 7) * 256) * 4096 + ((item0 >> 5) & 3) * 512; XLOAD(kvb0, 0); }
    for (int item = item0; item < item0 + 2; ++item) {
        const int b = item >> 7, head = (item >> 5) & 3, qb = item & 31;
        const size_t tok = (size_t)(b * SEQ + qb * 128 + 16 * w + idx);
        const bf16_t* qrow = (const bf16_t*)(ws + OFF_B1) + tok * DM + head * 512 + 8 * g;
        const bf16_t* kvb = (const bf16_t*)(ws + OFF_MKV) + (size_t)(b * 256) * 4096 + head * 512;
        f32x4 sc[16];
#pragma unroll
        for (int kt = 0; kt < 16; ++kt) sc[kt] = (f32x4){0.f, 0.f, 0.f, 0.f};
        for (int c = 0; c < 4; ++c) {
            LAS unsigned char* buf = lds + (c & 1) * KV_BUF;
            XSTORE(buf);
            bf16x8 qf[4];
#pragma unroll
            for (int ks = 0; ks < 4; ++ks) qf[ks] = *(const bf16x8*)(qrow + c * 128 + 32 * ks);
            XLOAD(kvb, c + 1);
            LDS_BARRIER();
#pragma unroll
            for (int kt = 0; kt < 16; ++kt)
#pragma unroll
                for (int ks = 0; ks < 4; ++ks) sc[kt] = mfma16(frag_row(buf, KV_STRIDE, 16 * kt, 32 * ks, idx, g), qf[ks], sc[kt]);
        }
        const float scl = 0.04419417382415922f * LOG2E;
        float mx = -1e30f;
#pragma unroll
        for (int kt = 0; kt < 16; ++kt)
#pragma unroll
            for (int rr = 0; rr < 4; ++rr) { const float sv = sc[kt][rr] * scl; sc[kt][rr] = sv; mx = fmaxf(mx, sv); }
        mx = fmaxf(mx, __shfl_xor(mx, 16)); mx = fmaxf(mx, __shfl_xor(mx, 32));
        float sum = 0.f;
#pragma unroll
        for (int kt = 0; kt < 16; ++kt)
#pragma unroll
            for (int rr = 0; rr < 4; ++rr) { const float e = fexp2(sc[kt][rr] - mx); sc[kt][rr] = e; sum += e; }
        sum += __shfl_xor(sum, 16); sum += __shfl_xor(sum, 32);
        const float inv = 1.0f / sum;
        bf16x8 pf[8];
#pragma unroll
        for (int sx = 0; sx < 8; ++sx) { u32x4 pw; pw.x = cvt_pk_bf16(sc[2 * sx][0], sc[2 * sx][1]); pw.y = cvt_pk_bf16(sc[2 * sx][2], sc[2 * sx][3]); pw.z = cvt_pk_bf16(sc[2 * sx + 1][0], sc[2 * sx + 1][1]); pw.w = cvt_pk_bf16(sc[2 * sx + 1][2], sc[2 * sx + 1][3]);
            pf[sx] = __builtin_bit_cast(bf16x8, pw); }
        const int nitem = (item + 1 < item0 + 2) ? item + 1 : 512;
        const bf16_t* nkvb = (const bf16_t*)(ws + OFF_MKV) + (size_t)(((nitem < 512 ? nitem : item) >> 7) * 256) * 4096 + (((nitem < 512 ? nitem : item) >> 5) & 3) * 512;
        for (int c = 0; c < 4; ++c) {
            LAS unsigned char* buf = lds + (c & 1) * KV_BUF;
            XSTORE(buf);
            if (c < 3) XLOAD(kvb, 5 + c); else XLOAD(nkvb, 0);
            LDS_BARRIER();
            f32x4 ot[8];
#pragma unroll
            for (int c8 = 0; c8 < 8; ++c8) ot[c8] = (f32x4){0.f, 0.f, 0.f, 0.f};
            const unsigned bb = lbase + (unsigned)((c & 1) * KV_BUF);
#pragma unroll
            for (int sx = 0; sx < 8; ++sx) {
                const unsigned aA = bb + (unsigned)((32 * sx + 4 * g + (idx >> 2)) * KV_STRIDE + 8 * (idx & 3));
                const unsigned aB = aA + 16u * KV_STRIDE;
                bf16x8 vf[4];
                tr_frag4(aA, aB, vf);
#pragma unroll
                for (int c8 = 0; c8 < 4; ++c8) ot[c8] = mfma16(vf[c8], pf[sx], ot[c8]);
                tr_frag4(aA + 128, aB + 128, vf);
#pragma unroll
                for (int c8 = 0; c8 < 4; ++c8) ot[4 + c8] = mfma16(vf[c8], pf[sx], ot[4 + c8]);
            }
#pragma unroll
            for (int c8 = 0; c8 < 8; ++c8) { u32x2 wv; wv.x = cvt_pk_bf16(ot[c8][0] * inv, ot[c8][1] * inv); wv.y = cvt_pk_bf16(ot[c8][2] * inv, ot[c8][3] * inv);
                *(u32x2*)(oc + tok * DM + head * 512 + c * 128 + 16 * c8 + 4 * g) = wv; }
        }
    }
#undef XLOAD
#undef XSTORE
    asm volatile("s_waitcnt vmcnt(0)" ::: "memory");
    __syncthreads();
}

__device__ void merge_phase(const Params& p) {
    const int tid_ = opaque_tid(); const int lane = tid_ & 63, wid = tid_ >> 6;
    unsigned char* ws = p.ws;
    const bf16_t* og = (const bf16_t*)(ws + OFF_OG); const bf16_t* h = (const bf16_t*)(ws + OFF_H);
    const bf16_t* od0 = (const bf16_t*)(ws + OFF_B2); const bf16_t* od1 = (const bf16_t*)(ws + OFF_B2 + 32 * MiB); const bf16_t* od2 = (const bf16_t*)(ws + OFF_OD2);
    const float* lse = (const float*)(ws + OFF_LSE);
    bf16_t* mix = (bf16_t*)(ws + OFF_B1);
    for (int tok = blockIdx.x * 8 + wid; tok < T_TOK; tok += gridDim.x * 8) {
        { const int hh = lane >> 4, sub = lane & 15;
          const bf16_t* src = og + (size_t)tok * 1024 + hh * 256 + sub * 16;
          const u32x4 a = *(const u32x4*)src, b = *(const u32x4*)(src + 8);
          float xv[16];
#pragma unroll
          for (int j = 0; j < 4; ++j) { xv[2 * j] = bflo(a[j]); xv[2 * j + 1] = bfhi(a[j]); xv[8 + 2 * j] = bflo(b[j]); xv[8 + 2 * j + 1] = bfhi(b[j]); }
          float s = 0.f;
#pragma unroll
          for (int j = 0; j < 16; ++j) s += xv[j];
          s += __shfl_xor(s, 1); s += __shfl_xor(s, 2); s += __shfl_xor(s, 4); s += __shfl_xor(s, 8);
          const float mean = s * (1.0f / 256.0f);
          float q = 0.f;
#pragma unroll
          for (int j = 0; j < 16; ++j) { const float dlt = xv[j] - mean; q += dlt * dlt; }
          q += __shfl_xor(q, 1); q += __shfl_xor(q, 2); q += __shfl_xor(q, 4); q += __shfl_xor(q, 8);
          const float rstd = rsqrtf(q * (1.0f / 256.0f) + 1e-5f);
          const bf16_t* rgp = h + (size_t)tok * HC + 2048 + hh * 256 + sub * 16;
          const u32x4 ra = *(const u32x4*)rgp, rb = *(const u32x4*)(rgp + 8);
          const float* ngp = p.norm_g + hh * 256 + sub * 16;
          float ov[16];
#pragma unroll
          for (int j4 = 0; j4 < 4; ++j4) { const f32x4 ng = *(const f32x4*)(ngp + 4 * j4);
#pragma unroll
              for (int j = 0; j < 4; ++j) { const int e = 4 * j4 + j; const unsigned rw = (e < 8) ? ra[e >> 1] : rb[(e - 8) >> 1]; const float rv = (e & 1) ? bfhi(rw) : bflo(rw);
                  ov[e] = (xv[e] - mean) * rstd * ng[j] * silu_f(rv); } }
          u32x4 o0, o1;
#pragma unroll
          for (int j = 0; j < 4; ++j) { o0[j] = cvt_pk_bf16(ov[2 * j], ov[2 * j + 1]); o1[j] = cvt_pk_bf16(ov[8 + 2 * j], ov[8 + 2 * j + 1]); }
          bf16_t* dst = mix + (size_t)tok * DM + hh * 256 + sub * 16;
          *(u32x4*)dst = o0; *(u32x4*)(dst + 8) = o1; }
        { const int hd = lane >> 3, sub = lane & 7;
          const float l0 = lse[(size_t)tok * 8 + hd], l1 = lse[(size_t)T_TOK * 8 + (size_t)tok * 8 + hd], l2 = lse[(size_t)2 * T_TOK * 8 + (size_t)tok * 8 + hd];
          const float m = fmaxf(l0, fmaxf(l1, l2));
          float e0 = fexp2((l0 - m) * LOG2E), e1 = fexp2((l1 - m) * LOG2E), e2 = fexp2((l2 - m) * LOG2E);
          const float inv = 1.0f / (e0 + e1 + e2); e0 *= inv; e1 *= inv; e2 *= inv;
          const size_t so = (size_t)tok * 1024 + hd * 128 + sub * 16;
          u32x4 o[2];
#pragma unroll
          for (int hf = 0; hf < 2; ++hf) { const u32x4 a = *(const u32x4*)(od0 + so + 8 * hf), b = *(const u32x4*)(od1 + so + 8 * hf), c = *(const u32x4*)(od2 + so + 8 * hf);
#pragma unroll
              for (int j = 0; j < 4; ++j) o[hf][j] = cvt_pk_bf16(e0 * bflo(a[j]) + e1 * bflo(b[j]) + e2 * bflo(c[j]), e0 * bfhi(a[j]) + e1 * bfhi(b[j]) + e2 * bfhi(c[j])); }
          bf16_t* dst = mix + (size_t)tok * DM + 1024 + hd * 128 + sub * 16;
          *(u32x4*)dst = o[0]; *(u32x4*)(dst + 8) = o[1]; }
    }
}

__device__ void ln_phase(float* io, const float* __restrict__ gam, const float* __restrict__ bet, bf16_t* ob) {
    const int tid_ = opaque_tid(); const int lane = tid_ & 63, wid = tid_ >> 6;
    for (int row = blockIdx.x * 8 + wid; row < T_TOK; row += gridDim.x * 8) {
        float* pr = io + (size_t)row * DM + lane * 4;
        f32x4 v[8]; float s = 0.f;
#pragma unroll
        for (int j = 0; j < 8; ++j) { v[j] = *(const f32x4*)(pr + 256 * j); s += (v[j][0] + v[j][1]) + (v[j][2] + v[j][3]); }
#pragma unroll
        for (int o = 32; o; o >>= 1) s += __shfl_xor(s, o);
        const float mean = s * (1.0f / 2048.0f);
        float q = 0.f;
#pragma unroll
        for (int j = 0; j < 8; ++j) { const f32x4 dlt = v[j] - mean; q += (dlt[0] * dlt[0] + dlt[1] * dlt[1]) + (dlt[2] * dlt[2] + dlt[3] * dlt[3]); }
#pragma unroll
        for (int o = 32; o; o >>= 1) q += __shfl_xor(q, o);
        const float rstd = rsqrtf(q * (1.0f / 2048.0f) + 1e-5f);
#pragma unroll
        for (int j = 0; j < 8; ++j) {
            const f32x4 gv = *(const f32x4*)(gam + lane * 4 + 256 * j), bv = *(const f32x4*)(bet + lane * 4 + 256 * j);
            const f32x4 y = (v[j] - mean) * rstd * gv + bv;
            if (!ob) *(f32x4*)(pr + 256 * j) = y;
            if (ob) { u32x2 wv; wv.x = cvt_pk_bf16(y[0], y[1]); wv.y = cvt_pk_bf16(y[2], y[3]); *(u32x2*)(ob + (size_t)row * DM + lane * 4 + 256 * j) = wv; }
        }
    }
}


__device__ void ln_phase2(const bf16_t* __restrict__ mix, const float* __restrict__ Rf, const bf16_t* __restrict__ Rb, const float* __restrict__ gam, const float* __restrict__ bet, bf16_t* ob, float* of) {
    const int tid_ = opaque_tid(); const int lane = tid_ & 63, wid = tid_ >> 6;
    for (int row = blockIdx.x * 8 + wid; row < T_TOK; row += gridDim.x * 8) {
        const size_t ro = (size_t)row * DM + lane * 8;
        float v[32]; float s = 0.f;
#pragma unroll
        for (int j = 0; j < 4; ++j) {
            const u32x4 m = *(const u32x4*)(mix + ro + 512 * j);
            float r[8];
            if (Rf) { const f32x4 a = *(const f32x4*)(Rf + ro + 512 * j), b = *(const f32x4*)(Rf + ro + 512 * j + 4);
                r[0] = a[0]; r[1] = a[1]; r[2] = a[2]; r[3] = a[3]; r[4] = b[0]; r[5] = b[1]; r[6] = b[2]; r[7] = b[3]; }
            else { const u32x4 rb = *(const u32x4*)(Rb + ro + 512 * j);
                r[0] = bflo(rb.x); r[1] = bfhi(rb.x); r[2] = bflo(rb.y); r[3] = bfhi(rb.y); r[4] = bflo(rb.z); r[5] = bfhi(rb.z); r[6] = bflo(rb.w); r[7] = bfhi(rb.w); }
            v[8 * j + 0] = DN_ALPHA * r[0] + bflo(m.x); v[8 * j + 1] = DN_ALPHA * r[1] + bfhi(m.x); v[8 * j + 2] = DN_ALPHA * r[2] + bflo(m.y); v[8 * j + 3] = DN_ALPHA * r[3] + bfhi(m.y);
            v[8 * j + 4] = DN_ALPHA * r[4] + bflo(m.z); v[8 * j + 5] = DN_ALPHA * r[5] + bfhi(m.z); v[8 * j + 6] = DN_ALPHA * r[6] + bflo(m.w); v[8 * j + 7] = DN_ALPHA * r[7] + bfhi(m.w);
#pragma unroll
            for (int e = 0; e < 8; ++e) s += v[8 * j + e];
        }
#pragma unroll
        for (int o = 32; o; o >>= 1) s += __shfl_xor(s, o);
        const float mean = s * (1.0f / 2048.0f);
        float q = 0.f;
#pragma unroll
        for (int e = 0; e < 32; ++e) { const float dlt = v[e] - mean; q += dlt * dlt; }
#pragma unroll
        for (int o = 32; o; o >>= 1) q += __shfl_xor(q, o);
        const float rstd = rsqrtf(q * (1.0f / 2048.0f) + 1e-5f);
#pragma unroll
        for (int j = 0; j < 4; ++j) {
            const f32x4 g0 = *(const f32x4*)(gam + lane * 8 + 512 * j), g1 = *(const f32x4*)(gam + lane * 8 + 512 * j + 4);
            const f32x4 b0 = *(const f32x4*)(bet + lane * 8 + 512 * j), b1 = *(const f32x4*)(bet + lane * 8 + 512 * j + 4);
            f32x4 y0, y1;
#pragma unroll
            for (int e = 0; e < 4; ++e) { y0[e] = (v[8 * j + e] - mean) * rstd * g0[e] + b0[e]; y1[e] = (v[8 * j + 4 + e] - mean) * rstd * g1[e] + b1[e]; }
            if (ob) { u32x4 w; w.x = cvt_pk_bf16(y0[0], y0[1]); w.y = cvt_pk_bf16(y0[2], y0[3]); w.z = cvt_pk_bf16(y1[0], y1[1]); w.w = cvt_pk_bf16(y1[2], y1[3]); *(u32x4*)(ob + ro + 512 * j) = w; }
            else { *(f32x4*)(of + ro + 512 * j) = y0; *(f32x4*)(of + ro + 512 * j + 4) = y1; }
        }
    }
}

__device__ void conv_phase(const Params& p, int half) {
    unsigned char* ws = p.ws;
    const bf16_t* u = (const bf16_t*)(ws + OFF_U); bf16_t* gout = (bf16_t*)(ws + OFF_G);
    constexpr int NCG = DFF / 8;
    for (int task = blockIdx.x * 512 + opaque_tid(); task < 512 * NCG; task += gridDim.x * 512) {
        const int cgp = task % NCG, tb = task / NCG, c = cgp * 8, r0 = tb * 16, t0 = half * 8192 + r0;
        float wg[3][8], wu[3][8], bg[8], bu[8];
#pragma unroll
        for (int i = 0; i < 3; ++i)
#pragma unroll
            for (int j4 = 0; j4 < 2; ++j4) { const f32x4 a = *(const f32x4*)(p.conv_w + (size_t)i * 11008 + c + 4 * j4), b = *(const f32x4*)(p.conv_w + (size_t)i * 11008 + DFF + c + 4 * j4);
#pragma unroll
                for (int j = 0; j < 4; ++j) { wg[i][4 * j4 + j] = a[j]; wu[i][4 * j4 + j] = b[j]; } }
#pragma unroll
        for (int j4 = 0; j4 < 2; ++j4) { const f32x4 a = *(const f32x4*)(p.conv_b + c + 4 * j4), b = *(const f32x4*)(p.conv_b + DFF + c + 4 * j4);
#pragma unroll
            for (int j = 0; j < 4; ++j) { bg[4 * j4 + j] = a[j]; bu[4 * j4 + j] = b[j]; } }
        float g2[8], g1[8], u2[8], u1[8];
        if ((t0 & (SEQ - 1)) == 0) {
#pragma unroll
            for (int j = 0; j < 8; ++j) { g2[j] = 0.f; g1[j] = 0.f; u2[j] = 0.f; u1[j] = 0.f; }
        } else {
            const u32x4 a2 = *(const u32x4*)(u + (size_t)(r0 - 2) * 11008 + c), a1 = *(const u32x4*)(u + (size_t)(r0 - 1) * 11008 + c);
            const u32x4 b2 = *(const u32x4*)(u + (size_t)(r0 - 2) * 11008 + DFF + c), b1 = *(const u32x4*)(u + (size_t)(r0 - 1) * 11008 + DFF + c);
#pragma unroll
            for (int j = 0; j < 4; ++j) { g2[2 * j] = bflo(a2[j]); g2[2 * j + 1] = bfhi(a2[j]); g1[2 * j] = bflo(a1[j]); g1[2 * j + 1] = bfhi(a1[j]);
                u2[2 * j] = bflo(b2[j]); u2[2 * j + 1] = bfhi(b2[j]); u1[2 * j] = bflo(b1[j]); u1[2 * j + 1] = bfhi(b1[j]); }
        }
#pragma unroll 2
        for (int rr = 0; rr < 16; ++rr) {
            const u32x4 a0 = *(const u32x4*)(u + (size_t)(r0 + rr) * 11008 + c), b0 = *(const u32x4*)(u + (size_t)(r0 + rr) * 11008 + DFF + c);
            float gc[8], uc[8], res[8];
#pragma unroll
            for (int j = 0; j < 4; ++j) { gc[2 * j] = bflo(a0[j]); gc[2 * j + 1] = bfhi(a0[j]); uc[2 * j] = bflo(b0[j]); uc[2 * j + 1] = bfhi(b0[j]); }
#pragma unroll
            for (int j = 0; j < 8; ++j) {
                const float yg = bg[j] + wg[0][j] * g2[j] + wg[1][j] * g1[j] + wg[2][j] * gc[j];
                const float yu = bu[j] + wu[0][j] * u2[j] + wu[1][j] * u1[j] + wu[2][j] * uc[j];
                res[j] = silu_f(yg) * yu;
                g2[j] = g1[j]; g1[j] = gc[j]; u2[j] = u1[j]; u1[j] = uc[j];
            }
            u32x4 o; o.x = cvt_pk_bf16(res[0], res[1]); o.y = cvt_pk_bf16(res[2], res[3]); o.z = cvt_pk_bf16(res[4], res[5]); o.w = cvt_pk_bf16(res[6], res[7]);
            *(u32x4*)(gout + (size_t)(t0 + rr) * DFF + c) = o;
        }
    }
}


__device__ void conv_fixup(const Params& p) {
    unsigned char* ws = p.ws;
    const float* hu = (const float*)(ws + OFF_U); bf16_t* gout = (bf16_t*)(ws + OFF_G);
    for (int task = blockIdx.x * 512 + opaque_tid(); task < 128 * DFF; task += gridDim.x * 512) {
        const int bd = task / DFF, c = task - bd * DFF, pm = bd >> 1, hb = bd & 1;
        if (hb == 0 && (pm & 15) == 0) continue;
        const int rp = (hb == 0) ? ((pm - 1) * 8 + 6) : (pm * 8 + 2), rc = pm * 8 + 4 * hb;
        float ug[4], uu[4];
        ug[0] = hu[((size_t)((rp + 0) * 2 + 0)) * DFF + c]; ug[1] = hu[((size_t)((rp + 1) * 2 + 0)) * DFF + c];
        ug[2] = hu[((size_t)((rc + 0) * 2 + 0)) * DFF + c]; ug[3] = hu[((size_t)((rc + 1) * 2 + 0)) * DFF + c];
        uu[0] = hu[((size_t)((rp + 0) * 2 + 1)) * DFF + c]; uu[1] = hu[((size_t)((rp + 1) * 2 + 1)) * DFF + c];
        uu[2] = hu[((size_t)((rc + 0) * 2 + 1)) * DFF + c]; uu[3] = hu[((size_t)((rc + 1) * 2 + 1)) * DFF + c];
        const float wg0 = p.conv_w[c], wg1 = p.conv_w[11008 + c], wg2 = p.conv_w[22016 + c], wu0 = p.conv_w[DFF + c], wu1 = p.conv_w[11008 + DFF + c], wu2 = p.conv_w[22016 + DFF + c];
        const float bg = p.conv_b[c], bu = p.conv_b[DFF + c];
#pragma unroll
        for (int e = 0; e < 2; ++e) {
            const float yg = bg + wg0 * ug[e] + wg1 * ug[e + 1] + wg2 * ug[e + 2];
            const float yu = bu + wu0 * uu[e] + wu1 * uu[e + 1] + wu2 * uu[e + 2];
            const float r = silu_f(yg) * yu;
            gout[(size_t)(pm * 256 + 128 * hb + e) * DFF + c] = (bf16_t)(cvt_pk_bf16(r, r) & 0xffffu);
        }
    }
}

#define XB_TMO      128
#define XB_XCNT(j)  (256  + 64 * (j))
#define XB_XSUB(j)  (1280 + 64 * (j))
#define XB_XGEN(j)  (2304 + 64 * (j))
#define XB_TOP      3328
#define XB_TOPGEN   3392
#define XCD_BAR_WORDS 3456
#define XB_SPIN_CAP (1u << 22)
__device__ __forceinline__ unsigned xb_ld(unsigned* p)              { return __hip_atomic_load(p, __ATOMIC_RELAXED, __HIP_MEMORY_SCOPE_AGENT); }
__device__ __forceinline__ unsigned xb_add(unsigned* p, unsigned v) { return __hip_atomic_fetch_add(p, v, __ATOMIC_RELAXED, __HIP_MEMORY_SCOPE_AGENT); }
__device__ __forceinline__ unsigned xb_xcc_id() { return (unsigned)__builtin_amdgcn_s_getreg((3 << 11) | 20) & 0xFu; }
#define XB_SPIN(cond, bar) do { unsigned _sp = 0; while (cond) { __builtin_amdgcn_s_sleep(1); \
    if ((++_sp & 255u) == 0u) { if (xb_ld(&(bar)[XB_TMO])) break; if (_sp > XB_SPIN_CAP) { atomicAdd(&(bar)[XB_TMO], 1u); break; } } } } while (0)
struct XcdBarrier { unsigned* bar; unsigned x; volatile LAS unsigned* st; };
__device__ __forceinline__ XcdBarrier xcd_barrier_post(unsigned* bar, volatile LAS unsigned* st) {
    XcdBarrier b; b.bar = bar; b.x = xb_xcc_id(); b.st = st;
    if (threadIdx.x == 0) (void)xb_add(&bar[XB_XCNT(b.x)], 1u);
    return b;
}
__device__ __forceinline__ void xcd_barrier_complete(unsigned* bar, unsigned x, unsigned& nloc, unsigned& nx) {
    const unsigned G = gridDim.x * gridDim.y * gridDim.z;
    unsigned sum, cnt, mine, sp = 0u;
    for (;;) {
        sum = 0u; cnt = 0u; mine = 0u;
#pragma unroll
        for (unsigned j = 0; j < 16; ++j) { const unsigned c = xb_ld(&bar[XB_XCNT(j)]); sum += c; cnt += (c > 0u) ? 1u : 0u; mine = (j == x) ? c : mine; }
        if (sum == G) break;
        __builtin_amdgcn_s_sleep(1);
        if ((++sp & 255u) == 0u) { if (xb_ld(&bar[XB_TMO])) break; if (sp > XB_SPIN_CAP) { atomicAdd(&bar[XB_TMO], 1u); break; } }
    }
    nloc = mine > 0u ? mine : 1u; nx = cnt > 0u ? cnt : 1u;
}
__device__ __forceinline__ void xcd_barrier(const XcdBarrier& b) {
    asm volatile("s_waitcnt vmcnt(0)" ::: "memory");
    __syncthreads();
    if (threadIdx.x == 0) {
        unsigned* bar = b.bar;
        __builtin_amdgcn_s_waitcnt(0);
        unsigned nloc = b.st[0], nx = b.st[1];
        if (nloc == 0u) { xcd_barrier_complete(bar, b.x, nloc, nx); b.st[0] = nloc; b.st[1] = nx; }
        const unsigned old = xb_add(&bar[XB_XSUB(b.x)], 1u);
        const unsigned gen = old / nloc;
        if (old + 1u == (gen + 1u) * nloc) {
            __builtin_amdgcn_fence(__ATOMIC_RELEASE, "agent");
            asm volatile("s_waitcnt vmcnt(0)" ::: "memory");
            const unsigned og = xb_add(&bar[XB_TOP], 1u);
            const unsigned tg = og / nx;
            if (og + 1u == (tg + 1u) * nx) xb_add(&bar[XB_TOPGEN], 1u);
            else XB_SPIN(xb_ld(&bar[XB_TOPGEN]) == tg, bar);
            __builtin_amdgcn_fence(__ATOMIC_ACQUIRE, "agent");
            xb_add(&bar[XB_XGEN(b.x)], 1u);
            asm volatile("s_waitcnt vmcnt(0)" ::: "memory");
        } else {
            XB_SPIN(xb_ld(&bar[XB_XGEN(b.x)]) == gen, bar);
            __builtin_amdgcn_fence(__ATOMIC_ACQUIRE, "agent");
            asm volatile("s_waitcnt vmcnt(0)" ::: "memory");
        }
    }
    __syncthreads();
}

constexpr int NPHASE = 14;
#ifndef REP_PH
#define REP_PH -1
#endif
#ifndef REP_SYNC
#define REP_SYNC 1
#endif
#ifndef REP_MODE
#define REP_MODE 0
#endif
#ifndef PHMASK
#define PHMASK 0xFFFFF
#endif
#define EN(x) (((PHMASK) >> (x)) & 1)
__global__ void __launch_bounds__(512, 2) fwd_megakernel(Params p) {
    extern __shared__ __attribute__((aligned(16))) unsigned char smem[];
    LAS unsigned char* lds = (LAS unsigned char*)smem;
    cg::grid_group grid = cg::this_grid();
    unsigned char* ws = p.ws;
    const int G = (int)gridDim.x, bid = (int)blockIdx.x;
    if (threadIdx.x < 2) *(LAS unsigned*)(lds + LDS_SLOT + 16 + 4 * threadIdx.x) = 0u;
    __syncthreads();
    const XcdBarrier xb = xcd_barrier_post((unsigned*)(ws + OFF_BAR), (volatile LAS unsigned*)(lds + LDS_SLOT + 16));
    if (p.ph_lo < 0) grid.sync();
    for (int ph = p.ph_lo; ph < p.ph_hi; ++ph) {
      for (int rep = 0; rep < ((ph == REP_PH) ? 2 : 1); ++rep) {
        GemmDesc gd; gd.M = 0; gd.R = nullptr; gd.rope = nullptr; gd.G = G; gd.c = bid; gd.rbf = 0; gd.order = 0; gd.pad2 = 0; gd.aux = nullptr; gd.mode = 0; gd.A = nullptr; gd.Bt = nullptr; gd.C = nullptr; gd.N = 0; gd.K = 0; gd.ldc = 0;
        switch (ph) {
        case 0: if (EN(0)) prep_phase(p, smem); break;
        case 1: gd.A = (const bf16_t*)(ws + OFF_B1); gd.Bt = (const bf16_t*)(ws + OFF_WIN); gd.C = ws + OFF_H; gd.rope = (const float*)(ws + OFF_ROPE); gd.aux = (float*)(ws + OFF_EB); gd.M = T_TOK; gd.N = HC; gd.K = DM; gd.ldc = HC; gd.mode = 1; break;
        case 2:
            if (bid < 64) { if (EN(1) && !(rep == 1 && REP_MODE == 2)) gla_item(p, bid, lds); }
            else if (bid < 128 && !(rep == 1 && REP_MODE != 0)) { gd.A = (const bf16_t*)(ws + OFF_MEMB); gd.Bt = (const bf16_t*)(ws + OFF_WKV); gd.C = ws + OFF_MKV; gd.M = 1024; gd.N = 4096; gd.K = DM; gd.ldc = 4096; gd.mode = 0; gd.G = 64; gd.c = bid - 64; }
            break;
        case 3: if (EN(2)) merge_phase(p); break;
        case 4: gd.A = (const bf16_t*)(ws + OFF_B1); gd.Bt = (const bf16_t*)(ws + OFF_WOUT); gd.C = ws + OFF_MIX4; gd.M = T_TOK; gd.N = DM; gd.K = DM; gd.ldc = DM; gd.mode = 0; break;
        case 5: if (EN(3)) ln_phase2((const bf16_t*)(ws + OFF_MIX4), p.x, nullptr, p.ln1_g, p.ln1_b, (bf16_t*)(ws + OFF_X1B), nullptr); break;
        case 6: gd.A = (const bf16_t*)(ws + OFF_X1B); gd.Bt = (const bf16_t*)(ws + OFF_WQ); gd.C = ws + OFF_B1; gd.M = T_TOK; gd.N = DM; gd.K = DM; gd.ldc = DM; gd.mode = 0; gd.order = 1; break;
        case 7: break;
        case 8: gd.A = (const bf16_t*)(ws + OFF_OC); gd.Bt = (const bf16_t*)(ws + OFF_WO); gd.C = ws + OFF_MIX8; gd.M = T_TOK; gd.N = DM; gd.K = DM; gd.ldc = DM; gd.mode = 0; break;
        case 9: if (EN(3)) ln_phase2((const bf16_t*)(ws + OFF_MIX8), nullptr, (const bf16_t*)(ws + OFF_X1B), p.ln2_g, p.ln2_b, (bf16_t*)(ws + OFF_B1), nullptr); if (EN(5)) ffn_weights(p, smem); break;
        case 10: gd.A = (const bf16_t*)(ws + OFF_B1); gd.Bt = (const bf16_t*)(ws + OFF_WF1); gd.C = ws + OFF_G; gd.R = p.conv_w; gd.rope = p.conv_b; gd.aux = (float*)(ws + OFF_U);
            gd.M = T_TOK; gd.N = 11008; gd.K = DM; gd.ldc = DFF; gd.mode = 3; break;
        case 11: if (EN(6)) conv_fixup(p); break;
        case 12: gd.A = (const bf16_t*)(ws + OFF_G); gd.Bt = (const bf16_t*)(ws + OFF_WF2); gd.C = ws + OFF_MIX12; gd.M = T_TOK; gd.N = DM; gd.K = DFF; gd.ldc = DM; gd.mode = 0; break;
        case 13: if (EN(3)) ln_phase2((const bf16_t*)(ws + OFF_MIX12), nullptr, (const bf16_t*)(ws + OFF_B1), p.ln3_g, p.ln3_b, nullptr, p.out); break;
        default: break;
        }
        if (EN(7)) if (gd.M) gemm_phase(lds, gd);
        if (ph == 6 && EN(4)) {
            if (threadIdx.x == 0) { __builtin_amdgcn_fence(__ATOMIC_ACQUIRE, "agent"); asm volatile("s_waitcnt vmcnt(0)" ::: "memory"); }
            __syncthreads();
            cross_items(p, lds);
        }
        if (ph == 10 && rep == 0 && bid >= 192) wt_run(p, 1, 1376 + (bid - 192), 64, 1376 + 688, smem);
        if (ph == 2 && !(rep == 1 && REP_MODE == 1)) {
            unsigned* ctr = (unsigned*)(ws + OFF_CTR) + rep;
            if (EN(8)) {
                if (threadIdx.x == 0) *(LAS int*)(lds + LDS_SLOT) = (int)atomicAdd(ctr, 1u);
                __syncthreads();
                int item = *(LAS int*)(lds + LDS_SLOT);
                __syncthreads();
                if (item < 3072) {
                    u32x4 pk[8], pv[8];
                    dil_preload(p, item, opaque_tid(), pk, pv);
                    while (item < 3072) {
                        if (threadIdx.x == 0) *(LAS int*)(lds + LDS_SLOT) = (int)atomicAdd(ctr, 1u);
                        LDS_BARRIER();
                        const int next = *(LAS int*)(lds + LDS_SLOT);
                        dilated_item(p, item, next, pk, pv, lds);
                        item = next;
                    }
                }
                asm volatile("s_waitcnt vmcnt(0)" ::: "memory");
                __syncthreads();
            }
            if (rep == 0) for (;;) {
                if (threadIdx.x == 0) *(LAS int*)(lds + LDS_SLOT) = (int)atomicAdd(ctr + 4, 1u);
                __syncthreads();
                const int j = *(LAS int*)(lds + LDS_SLOT);
                __syncthreads();
                if (j >= 768) break;
                wt_one(p, 0, j < 512 ? 768 + j : 1792 + (j - 512), smem);
            }
        }
      }
        if (ph + 1 < p.ph_hi && ph != 6) { for (int r = 0; r < REP_SYNC; ++r) xcd_barrier(xb); }
    }
}

extern "C" void kernel_launch(void* const* d_in, const int* in_sizes, int n_in, void* d_out, int out_size, void* d_ws, size_t ws_size, hipStream_t stream) {
    static int grid_blocks = 0;
    if (grid_blocks == 0) {
        if (ws_size < WS_NEED) { fprintf(stderr, "kernel_launch: workspace too small: %zu < %zu\n", ws_size, (size_t)WS_NEED); grid_blocks = -1; return; }
        int dev = 0, cus = 0, per_cu = 0;
        hipGetDevice(&dev);
        hipDeviceGetAttribute(&cus, hipDeviceAttributeMultiprocessorCount, dev);
        if (hipFuncSetAttribute((const void*)fwd_megakernel, hipFuncAttributeMaxDynamicSharedMemorySize, LDS_BYTES) != hipSuccess) { fprintf(stderr, "kernel_launch: hipFuncSetAttribute failed\n"); grid_blocks = -1; return; }
        hipOccupancyMaxActiveBlocksPerMultiprocessor(&per_cu, (const void*)fwd_megakernel, 512, LDS_BYTES);
        if (per_cu < 1) { fprintf(stderr, "kernel_launch: occupancy query says %d blocks per CU\n", per_cu); per_cu = 1; }
        if (per_cu > 1) per_cu = 1;
        grid_blocks = cus * per_cu;
        fprintf(stderr, "kernel_launch: grid %d (cus %d), ws %zu\n", grid_blocks, cus, ws_size);
    }
    if (grid_blocks < 0) return;
    Params p{};
    p.x = (const float*)d_in[0]; p.mem = (const float*)d_in[1]; p.pos = (const int*)d_in[2]; p.w_in = (const float*)d_in[3]; p.gate_w2 = (const float*)d_in[4]; p.gate_b = (const float*)d_in[5];
    p.norm_g = (const float*)d_in[6]; p.w_out = (const float*)d_in[7]; p.ln1_g = (const float*)d_in[8]; p.ln1_b = (const float*)d_in[9]; p.ca_wq = (const float*)d_in[10]; p.ca_wkv = (const float*)d_in[11];
    p.ca_wo = (const float*)d_in[12]; p.ln2_g = (const float*)d_in[13]; p.ln2_b = (const float*)d_in[14]; p.ffn_w_in = (const float*)d_in[15]; p.conv_w = (const float*)d_in[16]; p.conv_b = (const float*)d_in[17];
    p.ffn_w_out = (const float*)d_in[18]; p.ln3_g = (const float*)d_in[19]; p.ln3_b = (const float*)d_in[20];
    p.out = (float*)d_out; p.ws = (unsigned char*)d_ws;
#if ONE_LAUNCH
    if (hipMemsetAsync((unsigned char*)d_ws + OFF_BAR, 0, XCD_BAR_WORDS * 4, stream) != hipSuccess) { fprintf(stderr, "kernel_launch: memset of barrier words failed\n"); return; }
    p.ph_lo = 0; p.ph_hi = NPHASE;
    void* args[] = {&p};
    hipError_t e = hipLaunchCooperativeKernel((void*)fwd_megakernel, dim3(grid_blocks), dim3(512), args, LDS_BYTES, stream);
    if (e != hipSuccess) fprintf(stderr, "cooperative launch failed: %s (grid %d)\n", hipGetErrorString(e), grid_blocks);
#else
    for (int ph = 0; ph < NPHASE; ++ph) {
        p.ph_lo = ph; p.ph_hi = ph + 1;
        hipLaunchKernelGGL(fwd_megakernel, dim3(grid_blocks), dim3(512), LDS_BYTES, stream, p);
    }
#endif
}
```

```cpp
#include <hip/hip_runtime.h>
#include <hip/hip_cooperative_groups.h>
#include <cstdio>
namespace cg = cooperative_groups;

#ifndef ONE_LAUNCH
#define ONE_LAUNCH 1
#endif

#define LAS __attribute__((address_space(3)))
typedef unsigned short bf16_t;
typedef short bf16x8 __attribute__((ext_vector_type(8)));
typedef short s16x4 __attribute__((ext_vector_type(4)));
typedef float f32x4 __attribute__((ext_vector_type(4)));
typedef unsigned u32x4 __attribute__((ext_vector_type(4)));
typedef unsigned u32x2 __attribute__((ext_vector_type(2)));

constexpr int T_TOK = 16384, DM = 2048, SEQ = 4096, HC = 6144, DFF = 5504;
constexpr size_t MiB = 1ull << 20;
constexpr size_t OFF_B1 = 0;
constexpr size_t OFF_B2 = 64 * MiB;
constexpr size_t OFF_WIN = 128 * MiB, OFF_WOUT = 152 * MiB, OFF_WQ = 160 * MiB, OFF_WKV = 168 * MiB, OFF_WO = 184 * MiB;
constexpr size_t OFF_MEMB = 192 * MiB, OFF_MKV = 196 * MiB;
constexpr size_t OFF_LSE = 204 * MiB;
constexpr size_t OFF_CTR = 206 * MiB;
constexpr size_t OFF_ROPE = 206 * MiB + 4096;
constexpr size_t OFF_H = 209 * MiB;
constexpr size_t OFF_OC = 209 * MiB;
constexpr size_t OFF_MIX4 = 209 * MiB, OFF_MIX8 = 273 * MiB, OFF_MIX12 = 129 * MiB;
constexpr size_t OFF_X1B = 401 * MiB;
constexpr size_t OFF_OG = 401 * MiB;
constexpr size_t OFF_OD2 = 433 * MiB;
constexpr size_t OFF_EB = 465 * MiB, OFF_ENB = 481 * MiB;
constexpr size_t OFF_WF1 = 64 * MiB, OFF_WF2 = 107 * MiB;
constexpr size_t OFF_U = 129 * MiB;
constexpr size_t OFF_G = 301 * MiB;
constexpr size_t OFF_BAR = 500 * MiB;
constexpr size_t WS_NEED = 501 * MiB;

constexpr int LDS_BYTES = 143360;
constexpr int LDS_SLOT = 139264;
constexpr int KV_STRIDE = 272, KV_BUF = 256 * 272;

struct Params {
    const float* x; const float* mem; const int* pos; const float* w_in; const float* gate_w2; const float* gate_b; const float* norm_g;
    const float* w_out; const float* ln1_g; const float* ln1_b; const float* ca_wq; const float* ca_wkv; const float* ca_wo; const float* ln2_g; const float* ln2_b;
    const float* ffn_w_in; const float* conv_w; const float* conv_b; const float* ffn_w_out; const float* ln3_g; const float* ln3_b;
    float* out; unsigned char* ws; int ph_lo, ph_hi;
};

__constant__ float c_invf[16] = {1.000000000e+00f, 4.403665960e-01f, 1.939227432e-01f, 8.539710194e-02f, 3.760603070e-02f, 1.656043902e-02f, 7.292664610e-03f, 3.211445874e-03f,
                                 1.414213562e-03f, 6.227723788e-04f, 2.742481884e-04f, 1.207697351e-04f, 5.318296098e-05f, 2.341999971e-05f, 1.031338616e-05f, 4.541670478e-06f};

typedef float f32x2v __attribute__((ext_vector_type(2)));
typedef __bf16 b16x2v __attribute__((ext_vector_type(2)));
__device__ __forceinline__ unsigned cvt_pk_bf16(float lo, float hi) { const f32x2v v = {lo, hi}; const b16x2v r = __builtin_convertvector(v, b16x2v); return __builtin_bit_cast(unsigned, r); }
__device__ __forceinline__ float bflo(unsigned u) { return __uint_as_float(u << 16); }
__device__ __forceinline__ float bfhi(unsigned u) { return __uint_as_float(u & 0xffff0000u); }
__device__ __forceinline__ float fexp2(float x) { return __builtin_amdgcn_exp2f(x); }
__device__ __forceinline__ float flog2(float x) { return __builtin_amdgcn_logf(x); }
constexpr float LOG2E = 1.4426950408889634f, LN2 = 0.6931471805599453f;
__device__ __forceinline__ float silu_f(float v) { return v / (1.0f + fexp2(-v * LOG2E)); }

__device__ __forceinline__ int opaque_tid() { int t = (int)threadIdx.x; asm volatile("" : "+v"(t)); return t; }
__device__ __forceinline__ f32x4 mfma16(bf16x8 a, bf16x8 b, f32x4 c) { return __builtin_amdgcn_mfma_f32_16x16x32_bf16(a, b, c, 0, 0, 0); }

__device__ __forceinline__ bf16x8 frag_row(const LAS unsigned char* base, int stride, int row0, int k0, int idx, int g) {
    return *(const LAS bf16x8*)(base + (row0 + idx) * stride + (k0 + 8 * g) * 2);
}
__device__ __forceinline__ bf16x8 frag_tr(unsigned base_addr, int stride, int k0, int col0, int idx, int g) {
    const unsigned a0 = base_addr + (unsigned)((k0 + 8 * g + (idx >> 2)) * stride + (col0 + 4 * (idx & 3)) * 2);
    const unsigned a1 = a0 + 4u * (unsigned)stride;
    s16x4 r0, r1;
    asm volatile("ds_read_b64_tr_b16 %0, %2\n\tds_read_b64_tr_b16 %1, %3\n\ts_waitcnt lgkmcnt(0)" : "=&v"(r0), "=&v"(r1) : "v"(a0), "v"(a1) : "memory");
    bf16x8 f; f[0] = r0[0]; f[1] = r0[1]; f[2] = r0[2]; f[3] = r0[3]; f[4] = r1[0]; f[5] = r1[1]; f[6] = r1[2]; f[7] = r1[3]; return f;
}
__device__ __forceinline__ void tr_frag4(unsigned a, unsigned b, bf16x8 (&f)[4]) {
    s16x4 x0, x1, x2, x3, y0, y1, y2, y3;
    asm volatile("ds_read_b64_tr_b16 %0, %8\n\tds_read_b64_tr_b16 %1, %8 offset:32\n\tds_read_b64_tr_b16 %2, %8 offset:64\n\tds_read_b64_tr_b16 %3, %8 offset:96\n\t"
                 "ds_read_b64_tr_b16 %4, %9\n\tds_read_b64_tr_b16 %5, %9 offset:32\n\tds_read_b64_tr_b16 %6, %9 offset:64\n\tds_read_b64_tr_b16 %7, %9 offset:96\n\t"
                 "s_waitcnt lgkmcnt(0)"
                 : "=&v"(x0), "=&v"(x1), "=&v"(x2), "=&v"(x3), "=&v"(y0), "=&v"(y1), "=&v"(y2), "=&v"(y3) : "v"(a), "v"(b) : "memory");
#define MK(F, X, Y) F[0] = X[0]; F[1] = X[1]; F[2] = X[2]; F[3] = X[3]; F[4] = Y[0]; F[5] = Y[1]; F[6] = Y[2]; F[7] = Y[3];
    MK(f[0], x0, y0) MK(f[1], x1, y1) MK(f[2], x2, y2) MK(f[3], x3, y3)
#undef MK
}

constexpr int BM = 256, BK = 64, HALF = 128, HTB = HALF * BK * 2, NXCD = 8, WGM = 8;
__device__ __forceinline__ int lds_byte(int r, int c) { const int st = (r >> 4) * 2 + (c >> 5), rr = r & 15, cc = c & 31, ob = rr * 64 + cc * 2; return st * 1024 + (ob ^ (((ob >> 9) & 1) << 5)); }
__device__ __forceinline__ void stage_rc(int b, int& R, int& C) { const int st = b / 1024, sb = b % 1024, swz = sb ^ (((sb >> 9) & 1) << 5); R = (st >> 1) * 16 + swz / 64; C = (st & 1) * 32 + (swz % 64) / 2; }
__device__ __forceinline__ int perm32(int rho) { const int n = rho >> 4, i = rho & 15; return 8 * (i >> 2) + 4 * n + (i & 3); }

struct GemmDesc {
    const bf16_t* A; const bf16_t* Bt; void* C; const float* R; const float* rope; float* aux;
    int M, N, K, ldc, mode, G, c, rbf, order, pad2;
};
struct Unit { int pm, pn; };
__device__ __forceinline__ bool unit_next(const GemmDesc& d, int i, Unit& u) {
    if (d.order == 1) {
        if (i >= 2) return false;
        const int xcd = d.c & 7, j = d.c >> 3; u.pm = 8 * xcd + (j >> 2); u.pn = 2 * (j & 3) + i; return true;
    }
    const int nM = d.M / BM, nN = d.N / BM, nwg = nM * nN;
    const long L = (long)i * d.G + d.c; if (L >= nwg) return false;
    int wgid = (int)L; { const int q = nwg / NXCD, r = nwg % NXCD, xcd = wgid % NXCD, off = wgid / NXCD; wgid = (xcd < r ? xcd * (q + 1) : r * (q + 1) + (xcd - r) * q) + off; }
    const int nig = WGM * nN, gid = wgid / nig, fm = gid * WGM, gsz = (nM - fm) < WGM ? (nM - fm) : WGM;
    u.pm = fm + ((wgid % nig) % gsz); u.pn = (wgid % nig) / gsz; return true;
}
constexpr float DN_ALPHA = 1.189207115002721f;

__device__ __forceinline__ void gemm_epilogue(const GemmDesc& d, const f32x4 (&acc)[2][2][4][2], const Unit& u, int wr, int wc, int fr, int fq) {
    if (d.mode == 2) {
        const int row0 = u.pm * BM + wr * 64 + fr, col0 = u.pn * BM + wc * 32 + 4 * fq;
        float* C = (float*)d.C; const float* R = d.R;
#pragma unroll
        for (int ai = 0; ai < 2; ++ai)
#pragma unroll
            for (int m = 0; m < 4; ++m) {
                const size_t ro = (size_t)(row0 + ai * HALF + m * 16) * d.ldc + col0;
#pragma unroll
                for (int bj = 0; bj < 2; ++bj)
#pragma unroll
                    for (int n = 0; n < 2; ++n) {
                        f32x4 r;
                        if (d.rbf) { const u32x2 rb = *(const u32x2*)((const bf16_t*)d.R + ro + bj * HALF + n * 16); r[0] = bflo(rb.x); r[1] = bfhi(rb.x); r[2] = bflo(rb.y); r[3] = bfhi(rb.y); }
                        else r = *(const f32x4*)(R + ro + bj * HALF + n * 16);
                        *(f32x4*)(C + ro + bj * HALF + n * 16) = r * DN_ALPHA + acc[ai][bj][m][n]; }
            }
    } else {
        const int row0 = u.pm * BM + wr * 64 + fr, col0 = u.pn * BM + wc * 32 + 8 * fq;
        bf16_t* O = (bf16_t*)d.C;
        const bool ropet = (d.mode == 1) && (u.pn >= 12) && (u.pn < 20) && (wc == 0);
        const float qs = (d.mode == 1 && (u.pn < 2 || (u.pn >= 12 && u.pn < 16))) ? 0.08838834764831845f : 1.0f;
        const bool gate = (d.mode == 1) && (u.pn < 4);
        const bf16_t* gtab = (const bf16_t*)d.aux + (u.pn & 1) * 256 + wc * 32 + 8 * fq;
        const bool ginv = (u.pn >= 2);
#pragma unroll
        for (int ai = 0; ai < 2; ++ai)
#pragma unroll
            for (int m = 0; m < 4; ++m) {
                const int row = row0 + ai * HALF + m * 16;
                bf16_t* rowp = O + (size_t)row * d.ldc + col0;
                f32x4 c0 = {1.f, 1.f, 1.f, 1.f}, c1 = c0, s0 = {0.f, 0.f, 0.f, 0.f}, s1 = s0;
                if (ropet) { const float* tp = d.rope + (size_t)row * 32 + 8 * (fq & 1); c0 = *(const f32x4*)tp; c1 = *(const f32x4*)(tp + 4); s0 = *(const f32x4*)(tp + 16); s1 = *(const f32x4*)(tp + 20);
                    if (fq < 2) { s0 = -s0; s1 = -s1; } }
#pragma unroll
                for (int bj = 0; bj < 2; ++bj) {
                    f32x4 v0 = acc[ai][bj][m][0] * qs, v1 = acc[ai][bj][m][1] * qs;
                    if (gate) { const u32x4 e = *(const u32x4*)(gtab + (size_t)row * 512 + bj * HALF);
                        float f[8] = {bflo(e.x), bfhi(e.x), bflo(e.y), bfhi(e.y), bflo(e.z), bfhi(e.z), bflo(e.w), bfhi(e.w)};
                        if (ginv) {
#pragma unroll
                            for (int j = 0; j < 8; ++j) f[j] = __builtin_amdgcn_rcpf(f[j]); }
                        v0[0] *= f[0]; v0[1] *= f[1]; v0[2] *= f[2]; v0[3] *= f[3]; v1[0] *= f[4]; v1[1] *= f[5]; v1[2] *= f[6]; v1[3] *= f[7]; }
                    if (ropet) {
                        f32x4 p0, p1;
#pragma unroll
                        for (int j = 0; j < 4; ++j) { p0[j] = __shfl_xor(v0[j], 32); p1[j] = __shfl_xor(v1[j], 32); }
                        v0 = v0 * c0 + p0 * s0; v1 = v1 * c1 + p1 * s1;
                    }
                    u32x4 w; w.x = cvt_pk_bf16(v0[0], v0[1]); w.y = cvt_pk_bf16(v0[2], v0[3]); w.z = cvt_pk_bf16(v1[0], v1[1]); w.w = cvt_pk_bf16(v1[2], v1[3]);
                    *(u32x4*)(rowp + bj * HALF) = w;
                }
            }
    }
}


__device__ __forceinline__ f32x4 dpp_prev(f32x4 v) {
    f32x4 r;
#pragma unroll
    for (int j = 0; j < 4; ++j) { const float x = v[j]; r[j] = __int_as_float(__builtin_amdgcn_update_dpp(0, __float_as_int(x), 0x111, 0xF, 0xF, true)); }
    return r;
}
__device__ __forceinline__ void conv_epilogue(const GemmDesc& d, const f32x4 (&acc)[2][2][4][2], const Unit& u, int wr, int wc, int fr, int fq, LAS unsigned char* lds) {
    const int L = 16 * wr + fr;
    const bool seq_start = (u.pm & 15) == 0;
    const int ch0 = u.pn * 128 + wc * 32 + fq * 8;
    if (fr == 0 || fr == 15) {
        const int rbase = (fr == 0) ? 4 * wr : 4 * wr + 2;
#pragma unroll
        for (int e2 = 0; e2 < 2; ++e2)
#pragma unroll
            for (int bj = 0; bj < 2; ++bj)
#pragma unroll
                for (int n = 0; n < 2; ++n) {
                    const f32x4 v = (fr == 0) ? acc[0][bj][e2][n] : acc[1][bj][2 + e2][n];
                    *(f32x4*)(d.aux + ((size_t)((u.pm * 8 + rbase + e2) * 2 + bj)) * DFF + ch0 + 4 * n) = v;
                }
    }
    bf16_t* gout = (bf16_t*)d.C;
#pragma unroll
    for (int n = 0; n < 2; ++n) {
        const int ch = ch0 + 4 * n;
        const f32x4 wg0 = *(const f32x4*)(d.R + ch), wg1 = *(const f32x4*)(d.R + 11008 + ch), wg2 = *(const f32x4*)(d.R + 22016 + ch);
        const f32x4 wu0 = *(const f32x4*)(d.R + DFF + ch), wu1 = *(const f32x4*)(d.R + 11008 + DFF + ch), wu2 = *(const f32x4*)(d.R + 22016 + DFF + ch);
        const f32x4 bg = *(const f32x4*)(d.rope + ch), bu = *(const f32x4*)(d.rope + DFF + ch);
        f32x4 pg2 = dpp_prev(acc[1][0][2][n]), pg1 = dpp_prev(acc[1][0][3][n]), pu2 = dpp_prev(acc[1][1][2][n]), pu1 = dpp_prev(acc[1][1][3][n]);
        if (fr == 0) { pg2 = (f32x4){0.f, 0.f, 0.f, 0.f}; pg1 = pg2; pu2 = pg2; pu1 = pg2; }
#pragma unroll
        for (int e = 0; e < 8; ++e) {
            const f32x4 cg_ = acc[e >> 2][0][e & 3][n], cu_ = acc[e >> 2][1][e & 3][n];
            const f32x4 yg = bg + wg0 * pg2 + wg1 * pg1 + wg2 * cg_;
            const f32x4 yu = bu + wu0 * pu2 + wu1 * pu1 + wu2 * cu_;
            f32x4 r;
#pragma unroll
            for (int j = 0; j < 4; ++j) r[j] = silu_f(yg[j]) * yu[j];
            u32x2 pk; pk.x = cvt_pk_bf16(r[0], r[1]); pk.y = cvt_pk_bf16(r[2], r[3]);
            { const bool skip = (fr == 0) && (e < 2) && !(wr == 0 && seq_start);
              if (!skip) *(u32x2*)(gout + (size_t)(u.pm * 256 + 8 * L + e) * DFF + ch) = pk; }
            pg2 = pg1; pg1 = cg_; pu2 = pu1; pu1 = cu_;
        }
    }
}

__device__ __forceinline__ void gemm_phase(LAS unsigned char* lds, const GemmDesc& g) {
    const int tid = opaque_tid(), wid = __builtin_amdgcn_readfirstlane(tid >> 6), lane = tid & 63, wr = wid >> 2, wc = wid & 3, fr = lane & 15, fq = lane >> 4;
    const int K = g.K, nt = K / BK;
    const bool perm = (g.mode != 2);
    unsigned voffA[2], voffB[2];
#pragma unroll
    for (int i = 0; i < 2; ++i) { int R, C; stage_rc(tid * 16 + i * 8192, R, C); const int Rb = perm ? ((R & ~31) + perm32(R & 31)) : R;
        const int Ra = (g.mode == 3) ? (8 * (16 * (R >> 6) + (R & 15)) + ((R >> 4) & 3)) : R;
        voffA[i] = (unsigned)(Ra * K + C) * 2u; voffB[i] = (unsigned)(Rb * K + C) * 2u; }
    const size_t kstep = (size_t)(BK * 2);
    const size_t hstep = (size_t)HALF * K * 2;
    const size_t tstep = 2 * hstep;
    const size_t hstepA = (g.mode == 3) ? (size_t)4 * K * 2 : hstep;
    const unsigned ldsw = (unsigned)wid * 1024u;
    const int aoff = lds_byte(wr * 64 + fr, fq * 8), boff = lds_byte(wc * 32 + fr, fq * 8);
#define PG8_SA(b, h) (((b) * 2 + (h)) * HTB)
#define PG8_SB(b, h) ((4 + (b) * 2 + (h)) * HTB)
#define PG8_STAGE(bufoff, gbase, voff) do { _Pragma("unroll") for (int _i = 0; _i < 2; ++_i) \
        __builtin_amdgcn_global_load_lds((const unsigned*)((const char*)(gbase) + (voff)[_i]), (LAS unsigned*)(lds + (bufoff) + ldsw + _i * 8192), 16, 0, 0); } while (0)
#define PG8_LDA(dst, b, h) do { _Pragma("unroll") for (int m = 0; m < 4; ++m) _Pragma("unroll") for (int k = 0; k < 2; ++k) dst[m][k] = *(const LAS bf16x8*)(lds + PG8_SA(b, h) + aoff + m * 2048 + k * 1024); } while (0)
#define PG8_LDB(dst, b, h) do { _Pragma("unroll") for (int n = 0; n < 2; ++n) _Pragma("unroll") for (int k = 0; k < 2; ++k) dst[n][k] = *(const LAS bf16x8*)(lds + PG8_SB(b, h) + boff + n * 2048 + k * 1024); } while (0)
#define PG8_MMA(ai, bj, At, Bt) do { __builtin_amdgcn_s_setprio(1); _Pragma("unroll") for (int m = 0; m < 4; ++m) _Pragma("unroll") for (int n = 0; n < 2; ++n) _Pragma("unroll") for (int k = 0; k < 2; ++k) \
        acc[ai][bj][m][n] = __builtin_amdgcn_mfma_f32_16x16x32_bf16(Bt[n][k], At[m][k], acc[ai][bj][m][n], 0, 0, 0); __builtin_amdgcn_s_setprio(0); } while (0)
#define PG8_WAIT_V(n) asm volatile("s_waitcnt vmcnt(" #n ")" ::: "memory")
#define PG8_WAIT_L(n) asm volatile("s_waitcnt lgkmcnt(" #n ")" ::: "memory")
#define PG8_BAR __builtin_amdgcn_s_barrier()
#define PG8_SCHED __builtin_amdgcn_sched_barrier(0)
    Unit cur, nxt; int ui = 0;
    if (!unit_next(g, 0, cur)) return;
    f32x4 acc[2][2][4][2];
#pragma unroll
    for (int a = 0; a < 2; ++a)
#pragma unroll
        for (int b = 0; b < 2; ++b)
#pragma unroll
            for (int m = 0; m < 4; ++m)
#pragma unroll
                for (int n = 0; n < 2; ++n) acc[a][b][m][n] = (f32x4){0.f, 0.f, 0.f, 0.f};
    bf16x8 At[4][2], B0[2][2], B1[2][2];
    const char* cA = (const char*)g.A + (size_t)cur.pm * tstep; const char* cB = (const char*)g.Bt + (size_t)cur.pn * tstep;
    PG8_STAGE(PG8_SB(0, 0), cB, voffB); PG8_STAGE(PG8_SA(0, 0), cA, voffA); PG8_STAGE(PG8_SB(0, 1), cB + hstep, voffB); PG8_STAGE(PG8_SA(0, 1), cA + hstepA, voffA);
    if (wr == 1) PG8_BAR;
    PG8_WAIT_V(4); PG8_BAR;
    PG8_STAGE(PG8_SB(1, 0), cB + kstep, voffB); PG8_STAGE(PG8_SA(1, 0), cA + kstep, voffA); PG8_STAGE(PG8_SB(1, 1), cB + hstep + kstep, voffB);
    PG8_WAIT_V(6); PG8_BAR;
    for (;;) {
        const bool has_next = unit_next(g, ui + 1, nxt);
        const char* nA = has_next ? (const char*)g.A + (size_t)nxt.pm * tstep : cA; const char* nB = has_next ? (const char*)g.Bt + (size_t)nxt.pn * tstep : cB;
        for (int t = 0; t < nt; t += 2) {
            const bool last = (t == nt - 2);
            const char* a1 = cA + (size_t)(t + 1) * kstep;
            const char* a2 = last ? nA : cA + (size_t)(t + 2) * kstep; const char* b2 = last ? nB : cB + (size_t)(t + 2) * kstep;
            const char* a3 = a2 + kstep; const char* b3 = b2 + kstep;
            PG8_LDB(B0, 0, 0); PG8_SCHED; PG8_LDA(At, 0, 0); PG8_STAGE(PG8_SA(1, 1), a1 + hstepA, voffA);
            PG8_WAIT_L(8); PG8_BAR; PG8_WAIT_L(0); PG8_MMA(0, 0, At, B0); PG8_BAR; PG8_SCHED;
            PG8_LDB(B1, 0, 1); PG8_STAGE(PG8_SB(0, 0), b2, voffB);
            PG8_BAR; PG8_WAIT_L(0); PG8_MMA(0, 1, At, B1); PG8_BAR;
            PG8_LDA(At, 0, 1); PG8_STAGE(PG8_SA(0, 0), a2, voffA);
            PG8_BAR; PG8_WAIT_L(0); PG8_MMA(1, 0, At, B0); PG8_BAR; PG8_SCHED;
            PG8_STAGE(PG8_SB(0, 1), b2 + hstep, voffB);
            PG8_WAIT_V(6); PG8_BAR; PG8_MMA(1, 1, At, B1); PG8_BAR;
            PG8_LDB(B0, 1, 0); PG8_SCHED; PG8_LDA(At, 1, 0); PG8_STAGE(PG8_SA(0, 1), a2 + hstepA, voffA);
            PG8_WAIT_L(8); PG8_BAR; PG8_WAIT_L(0); PG8_MMA(0, 0, At, B0); PG8_BAR; PG8_SCHED;
            PG8_LDB(B1, 1, 1); PG8_STAGE(PG8_SB(1, 0), b3, voffB);
            PG8_BAR; PG8_WAIT_L(0); PG8_MMA(0, 1, At, B1); PG8_BAR;
            PG8_LDA(At, 1, 1); PG8_STAGE(PG8_SA(1, 0), a3, voffA);
            PG8_BAR; PG8_WAIT_L(0); PG8_MMA(1, 0, At, B0); PG8_BAR; PG8_SCHED;
            PG8_STAGE(PG8_SB(1, 1), b3 + hstep, voffB);
            PG8_WAIT_V(6); PG8_BAR; PG8_MMA(1, 1, At, B1); PG8_BAR;
        }
        if (g.mode == 3) conv_epilogue(g, acc, cur, wr, wc, fr, fq, lds); else gemm_epilogue(g, acc, cur, wr, wc, fr, fq);
        if (!has_next) break;
#pragma unroll
        for (int a = 0; a < 2; ++a)
#pragma unroll
            for (int b = 0; b < 2; ++b)
#pragma unroll
                for (int m = 0; m < 4; ++m)
#pragma unroll
                    for (int n = 0; n < 2; ++n) acc[a][b][m][n] = (f32x4){0.f, 0.f, 0.f, 0.f};
        cur = nxt; cA = nA; cB = nB; ++ui;
    }
    PG8_WAIT_V(0);
    if (wr == 0) PG8_BAR;
    PG8_BAR;
#undef PG8_SA
#undef PG8_SB
#undef PG8_STAGE
#undef PG8_LDA
#undef PG8_LDB
#undef PG8_MMA
#undef PG8_WAIT_V
#undef PG8_WAIT_L
#undef PG8_BAR
#undef PG8_SCHED
}

__device__ __forceinline__ void wt_tile(const float* __restrict__ W, int ldw, int k0, int n0src, bf16_t* __restrict__ Bt, int K, int n0dst, float* tile) {
    const int tid = opaque_tid();
    { const int r = tid >> 4, c4 = tid & 15;
#pragma unroll
      for (int i = 0; i < 2; ++i) { const f32x4 v = *(const f32x4*)(W + (size_t)(k0 + r + 32 * i) * ldw + n0src + 4 * c4); float* tp = tile + (r + 32 * i) * 65 + 4 * c4; tp[0] = v[0]; tp[1] = v[1]; tp[2] = v[2]; tp[3] = v[3]; } }
    __syncthreads();
    { const int n = tid >> 3, kg = tid & 7; float v[8];
#pragma unroll
      for (int e = 0; e < 8; ++e) v[e] = tile[(8 * kg + e) * 65 + n];
      u32x4 w; w.x = cvt_pk_bf16(v[0], v[1]); w.y = cvt_pk_bf16(v[2], v[3]); w.z = cvt_pk_bf16(v[4], v[5]); w.w = cvt_pk_bf16(v[6], v[7]);
      *(u32x4*)(Bt + (size_t)(n0dst + n) * K + k0 + 8 * kg) = w; }
    __syncthreads();
}


struct WtDesc { const float* W; bf16_t* Bt; int ldw, k0, ns0, ns1, K, n0dst; };
__device__ __forceinline__ WtDesc wt_decode(const Params& p, int grp, int tl) {
    WtDesc d; unsigned char* ws = p.ws;
    if (grp == 0) {
        if (tl < 768)       { const int kt = tl & 31, nt = tl >> 5; const int n0 = nt * 256, s0 = n0 + (n0 >= 3072 ? 16 : 0); d.W = p.w_in; d.ldw = 6160; d.k0 = kt * 64; d.ns0 = s0; d.ns1 = s0 + 128; d.Bt = (bf16_t*)(ws + OFF_WIN); d.K = 2048; d.n0dst = n0; }
        else if (tl < 1024) { const int q = tl - 768;  d.W = p.w_out;  d.ldw = 2048; d.k0 = (q & 31) * 64; d.ns0 = (q >> 5) * 256; d.ns1 = d.ns0 + 128; d.Bt = (bf16_t*)(ws + OFF_WOUT); d.K = 2048; d.n0dst = d.ns0; }
        else if (tl < 1280) { const int q = tl - 1024; d.W = p.ca_wq;  d.ldw = 2048; d.k0 = (q & 31) * 64; d.ns0 = (q >> 5) * 256; d.ns1 = d.ns0 + 128; d.Bt = (bf16_t*)(ws + OFF_WQ);   d.K = 2048; d.n0dst = d.ns0; }
        else if (tl < 1792) { const int q = tl - 1280; d.W = p.ca_wkv; d.ldw = 4096; d.k0 = (q & 31) * 64; d.ns0 = (q >> 5) * 256; d.ns1 = d.ns0 + 128; d.Bt = (bf16_t*)(ws + OFF_WKV);  d.K = 2048; d.n0dst = d.ns0; }
        else                { const int q = tl - 1792; d.W = p.ca_wo;  d.ldw = 2048; d.k0 = (q & 31) * 64; d.ns0 = (q >> 5) * 256; d.ns1 = d.ns0 + 128; d.Bt = (bf16_t*)(ws + OFF_WO);   d.K = 2048; d.n0dst = d.ns0; }
    } else {
        if (tl < 1376) { const int kt = tl & 31, pn = tl >> 5; d.W = p.ffn_w_in; d.ldw = 11008; d.k0 = kt * 64; d.ns0 = pn * 128; d.ns1 = DFF + pn * 128; d.Bt = (bf16_t*)(ws + OFF_WF1); d.K = 2048; d.n0dst = pn * 256; }
        else { const int q = tl - 1376; const int kt = q % 86, nt = q / 86; d.W = p.ffn_w_out; d.ldw = 2048; d.k0 = kt * 64; d.ns0 = nt * 256; d.ns1 = d.ns0 + 128; d.Bt = (bf16_t*)(ws + OFF_WF2); d.K = DFF; d.n0dst = nt * 256; }
    }
    return d;
}
__device__ __forceinline__ void wt_load(const WtDesc& d, int tid, f32x4 (&v)[8]) {
    const int r = tid >> 6, c4 = tid & 63; const int col = (c4 < 32) ? d.ns0 + 4 * c4 : d.ns1 + 4 * (c4 - 32);
#pragma unroll
    for (int i = 0; i < 8; ++i) v[i] = *(const f32x4*)(d.W + (size_t)(d.k0 + r + 8 * i) * d.ldw + col);
}
__device__ __forceinline__ int wt_remap(int grp, int t) { return (grp == 2) ? (t < 768 ? t : t + 512) : t; }
__device__ void wt_run(const Params& p, int grp, int first, int stride, int ntiles, unsigned char* smem_g) {
    constexpr int LD = 260;
    float* tile = (float*)smem_g;
    const int tid = opaque_tid();
    int tl = first;
    if (tl >= ntiles) return;
    const int dg = (grp == 2) ? 0 : grp;
    WtDesc cur = wt_decode(p, dg, wt_remap(grp, tl)); f32x4 v[8];
    wt_load(cur, tid, v);
    for (;;) {
        { const int r = tid >> 6, c4 = tid & 63;
#pragma unroll
          for (int i = 0; i < 8; ++i) *(f32x4*)(tile + (r + 8 * i) * LD + 4 * c4) = v[i]; }
        const int nxt = tl + stride; const bool has = nxt < ntiles;
        WtDesc nd = cur;
        if (has) { nd = wt_decode(p, dg, wt_remap(grp, nxt)); wt_load(nd, tid, v); }
        __syncthreads();
        { const int n = tid >> 1, kh = tid & 1;
#pragma unroll
          for (int q = 0; q < 4; ++q) {
              float e[8];
#pragma unroll
              for (int j = 0; j < 8; ++j) e[j] = tile[(32 * kh + 8 * q + j) * LD + n];
              u32x4 w; w.x = cvt_pk_bf16(e[0], e[1]); w.y = cvt_pk_bf16(e[2], e[3]); w.z = cvt_pk_bf16(e[4], e[5]); w.w = cvt_pk_bf16(e[6], e[7]);
              *(u32x4*)(cur.Bt + (size_t)(cur.n0dst + n) * cur.K + cur.k0 + 32 * kh + 8 * q) = w;
          } }
        __syncthreads();
        if (!has) break;
        tl = nxt; cur = nd;
    }
}


__device__ void wt_one(const Params& p, int grp, int tl, unsigned char* smem_g) {
    constexpr int LD = 260;
    float* tile = (float*)smem_g;
    const int tid = opaque_tid();
    const WtDesc cur = wt_decode(p, grp, tl); f32x4 v[8];
    wt_load(cur, tid, v);
    { const int r = tid >> 6, c4 = tid & 63;
#pragma unroll
      for (int i = 0; i < 8; ++i) *(f32x4*)(tile + (r + 8 * i) * LD + 4 * c4) = v[i]; }
    __syncthreads();
    { const int n = tid >> 1, kh = tid & 1;
#pragma unroll
      for (int q = 0; q < 4; ++q) {
          float e[8];
#pragma unroll
          for (int j = 0; j < 8; ++j) e[j] = tile[(32 * kh + 8 * q + j) * LD + n];
          u32x4 w; w.x = cvt_pk_bf16(e[0], e[1]); w.y = cvt_pk_bf16(e[2], e[3]); w.z = cvt_pk_bf16(e[4], e[5]); w.w = cvt_pk_bf16(e[6], e[7]);
          *(u32x4*)(cur.Bt + (size_t)(cur.n0dst + n) * cur.K + cur.k0 + 32 * kh + 8 * q) = w;
      } }
    __syncthreads();
}

__device__ void prep_phase(const Params& p, unsigned char* smem_g) {
    const int tid = opaque_tid(), lane = tid & 63, wid = tid >> 6, idx = lane & 15, g = lane >> 4;
    unsigned char* ws = p.ws;
    float* red = (float*)smem_g;
    float* glrs = (float*)(smem_g + 32768);
    if (blockIdx.x == 0 && tid < 64) ((unsigned*)(ws + OFF_CTR))[tid] = 0u;
    bf16_t* xb = (bf16_t*)(ws + OFF_B1);
    bf16_t* ebp = (bf16_t*)(ws + OFF_EB); bf16_t* enbp = (bf16_t*)(ws + OFF_ENB);
    for (int ch = blockIdx.x; ch < T_TOK / 64; ch += gridDim.x) {
        const int t0 = ch * 64;
        const int wk = (wid + (int)blockIdx.x) & 7, mrot = ((int)blockIdx.x >> 3) & 3;
        bf16x8 bfr[8];
#pragma unroll
        for (int ks = 0; ks < 8; ++ks) {
            float v[8];
#pragma unroll
            for (int e = 0; e < 8; ++e) v[e] = p.w_in[(size_t)(256 * wk + 32 * ks + 8 * g + e) * 6160 + 3072 + idx];
            u32x4 w; w.x = cvt_pk_bf16(v[0], v[1]); w.y = cvt_pk_bf16(v[2], v[3]); w.z = cvt_pk_bf16(v[4], v[5]); w.w = cvt_pk_bf16(v[6], v[7]);
            bfr[ks] = __builtin_bit_cast(bf16x8, w);
        }
        f32x4 acc[4];
#pragma unroll
        for (int mt = 0; mt < 4; ++mt) {
            acc[mt] = (f32x4){0.f, 0.f, 0.f, 0.f};
#pragma unroll
            for (int ks = 0; ks < 8; ++ks) {
                const size_t off = (size_t)(t0 + 16 * ((mt + mrot) & 3) + idx) * DM + 256 * wk + 32 * ks + 8 * g;
                const f32x4 a = *(const f32x4*)(p.x + off), b = *(const f32x4*)(p.x + off + 4);
                u32x4 w; w.x = cvt_pk_bf16(a[0], a[1]); w.y = cvt_pk_bf16(a[2], a[3]); w.z = cvt_pk_bf16(b[0], b[1]); w.w = cvt_pk_bf16(b[2], b[3]);
                *(u32x4*)(xb + off) = w;
                acc[mt] = mfma16(__builtin_bit_cast(bf16x8, w), bfr[ks], acc[mt]);
            }
        }
#pragma unroll
        for (int mt = 0; mt < 4; ++mt)
#pragma unroll
            for (int r = 0; r < 4; ++r) red[(wid * 64 + 16 * ((mt + mrot) & 3) + 4 * g + r) * 16 + idx] = acc[mt][r];
        __syncthreads();
        { const int tok = tid >> 3, c2 = (tid & 7) * 2; float s0 = 0.f, s1 = 0.f;
#pragma unroll
          for (int w = 0; w < 8; ++w) { s0 += red[(w * 64 + tok) * 16 + c2]; s1 += red[(w * 64 + tok) * 16 + c2 + 1]; }
          glrs[tok * 16 + c2] = s0; glrs[tok * 16 + c2 + 1] = s1; }
        __syncthreads();
        { const int c = tid; float w2c[16];
#pragma unroll
          for (int r = 0; r < 16; ++r) w2c[r] = p.gate_w2[r * 512 + c];
          const float bias = p.gate_b[c]; float b2 = 0.f;
          for (int t = 0; t < 64; ++t) {
              float z = bias;
#pragma unroll
              for (int r4 = 0; r4 < 4; ++r4) { const f32x4 gv = *(const f32x4*)(glrs + t * 16 + 4 * r4); z += gv[0] * w2c[4 * r4] + gv[1] * w2c[4 * r4 + 1] + gv[2] * w2c[4 * r4 + 2] + gv[3] * w2c[4 * r4 + 3]; }
              const float az = fabsf(z);
              const float ls2 = fminf(z, 0.f) * LOG2E - flog2(1.0f + fexp2(-az * LOG2E));
              b2 += ls2 * 0.0625f;
              const float e = fexp2(b2);
              ebp[(size_t)(t0 + t) * 512 + c] = (bf16_t)(cvt_pk_bf16(e, e) & 0xffffu);
          } }
        __syncthreads();
    }
    { float* tab = (float*)(ws + OFF_ROPE);
      for (int e = blockIdx.x * 512 + tid; e < T_TOK * 16; e += gridDim.x * 512) {
          const int tok = e >> 4, i = e & 15;
          const float ang = (float)p.pos[tok] * c_invf[i];
          const double rev = (double)ang * 0.15915494309189535; const float fr = (float)(rev - rint(rev));
          tab[tok * 32 + i] = __builtin_amdgcn_cosf(fr); tab[tok * 32 + 16 + i] = __builtin_amdgcn_sinf(fr);
      } }
    { bf16_t* mb = (bf16_t*)(ws + OFF_MEMB);
      for (int e = blockIdx.x * 512 + tid; e < 1024 * 2048 / 4; e += gridDim.x * 512) { const f32x4 v = *(const f32x4*)(p.mem + (size_t)e * 4); u32x2 w; w.x = cvt_pk_bf16(v[0], v[1]); w.y = cvt_pk_bf16(v[2], v[3]); *(u32x2*)(mb + (size_t)e * 4) = w; } }
    wt_run(p, 2, (int)blockIdx.x, (int)gridDim.x, 1280, smem_g);
}

__device__ void ffn_weights(const Params& p, unsigned char* smem_g) { wt_run(p, 1, (int)blockIdx.x, (int)gridDim.x, 1376, smem_g); }

struct GlaRegs { u32x4 rq[2], rk[2], rv; u32x2 rdec; };
#define GLD(dst, ptr) asm volatile("global_load_dwordx4 %0, %1, off" : "=v"(dst) : "v"(ptr) : "memory")
#define GLD2(dst, ptr) asm volatile("global_load_dwordx2 %0, %1, off" : "=v"(dst) : "v"(ptr) : "memory")
__device__ __forceinline__ void gla_load(GlaRegs& R, int n, int t, const bf16_t* hq, const bf16_t* hv, const bf16_t* pdec) {
    const size_t tk = (size_t)(n * 64 + t);
    const bf16_t* a0 = hq + tk * HC; const bf16_t* a3 = pdec + (size_t)(n * 64 + 63) * 512; const bf16_t* a4 = hv + tk * HC;
    GLD(R.rq[0], a0); GLD(R.rq[1], a0 + 8); GLD(R.rk[0], a0 + 512); GLD(R.rk[1], a0 + 520); GLD(R.rv, a4); GLD2(R.rdec, a3);
}
__device__ __forceinline__ void gla_wait(GlaRegs& R, bool first) {
    if (first) asm volatile("s_waitcnt vmcnt(6)" : "+v"(R.rq[0]), "+v"(R.rq[1]), "+v"(R.rk[0]), "+v"(R.rk[1]), "+v"(R.rv), "+v"(R.rdec) :: "memory");
    else       asm volatile("s_waitcnt vmcnt(10)" : "+v"(R.rq[0]), "+v"(R.rq[1]), "+v"(R.rk[0]), "+v"(R.rk[1]), "+v"(R.rv), "+v"(R.rdec) :: "memory");
}
#define MKF(F, X, Y) F[0] = X[0]; F[1] = X[1]; F[2] = X[2]; F[3] = X[3]; F[4] = Y[0]; F[5] = Y[1]; F[6] = Y[2]; F[7] = Y[3];
#define LDS_BARRIER() do { asm volatile("s_waitcnt lgkmcnt(0)" ::: "memory"); __builtin_amdgcn_s_barrier(); asm volatile("" ::: "memory"); } while (0)
__device__ void gla_item(const Params& p, int item, LAS unsigned char* lds) {
    const int tid = opaque_tid(), lane = tid & 63, w = __builtin_amdgcn_readfirstlane(tid >> 6), idx = lane & 15, g = lane >> 4;
    const int b = item >> 4, hh = (item >> 2) & 3, sl = item & 3;
    constexpr int QS0 = 0, KS = 34816, VS0 = 52224, ST0 = 70656, AS = 105472;
    const unsigned lbase = (unsigned)(size_t)lds;
    unsigned char* ws = p.ws;
    const bf16_t* h = (const bf16_t*)(ws + OFF_H);
    bf16_t* og = (bf16_t*)(ws + OFF_OG);
    const int t = tid >> 3, cgp = tid & 7;
    const bf16_t* hq = h + (size_t)(b * SEQ) * HC + hh * 128 + cgp * 16;
    const bf16_t* hv = h + (size_t)(b * SEQ) * HC + 1024 + hh * 256 + sl * 64 + cgp * 8;
    const bf16_t* pdec = (const bf16_t*)(ws + OFF_EB) + (size_t)(b * SEQ) * 512 + hh * 128 + 16 * w + 4 * g;
    { unsigned zz = 0u; asm volatile("" : "+v"(zz)); const u32x4 zv = {zz, zz, zz, zz};
      for (int i = tid; i < 17408 / 16; i += 512) *(LAS u32x4*)(lds + ST0 + i * 16) = zv; }
    f32x4 S[4];
#pragma unroll
    for (int i = 0; i < 4; ++i) S[i] = (f32x4){0.f, 0.f, 0.f, 0.f};
    const int jt = w >> 1, it0 = 2 * (w & 1);
    GlaRegs RA, RB;
    gla_load(RA, 0, t, hq, hv, pdec); gla_load(RB, 1, t, hq, hv, pdec);
    for (int n2 = 0; n2 < 64; n2 += 2) {
#pragma unroll
      for (int par = 0; par < 2; ++par) {
        const int n = n2 + par;
        GlaRegs& R = par ? RB : RA;
        const int qs = QS0 + par * 17408, vs = VS0 + par * 9216, stc = ST0 + par * 17408, stn = ST0 + (par ^ 1) * 17408;
        gla_wait(R, n2 == 0);
        *(LAS u32x4*)(lds + qs + t * 272 + cgp * 32) = R.rq[0]; *(LAS u32x4*)(lds + qs + t * 272 + cgp * 32 + 16) = R.rq[1];
        *(LAS u32x4*)(lds + KS + t * 272 + cgp * 32) = R.rk[0]; *(LAS u32x4*)(lds + KS + t * 272 + cgp * 32 + 16) = R.rk[1];
        *(LAS u32x4*)(lds + vs + t * 144 + cgp * 16) = R.rv;
        f32x4 dc; dc[0] = bflo(R.rdec.x); dc[1] = bfhi(R.rdec.x); dc[2] = bflo(R.rdec.y); dc[3] = bfhi(R.rdec.y);
        asm volatile("" : "+v"(dc) :: "memory");
        gla_load(R, (n + 2 < 64) ? n + 2 : 63, t, hq, hv, pdec);
        LDS_BARRIER();
        const unsigned kaddr = lbase + KS + (unsigned)((8 * g + (idx >> 2)) * 272 + (16 * w + 4 * (idx & 3)) * 2);
        const unsigned vaddr = lbase + vs + (unsigned)((8 * g + (idx >> 2)) * 144 + (4 * (idx & 3)) * 2);
        s16x4 k00, k01, k10, k11, a0, a1, a2, a3, b0, b1, b2, b3, c0, c1, c2, c3, d0, d1, d2, d3;
        asm volatile(
              "ds_read_b64_tr_b16 %0, %20\n\tds_read_b64_tr_b16 %1, %20 offset:1088\n\tds_read_b64_tr_b16 %2, %20 offset:8704\n\tds_read_b64_tr_b16 %3, %20 offset:9792\n\t"
              "ds_read_b64_tr_b16 %4, %21\n\tds_read_b64_tr_b16 %5, %21 offset:32\n\tds_read_b64_tr_b16 %6, %21 offset:64\n\tds_read_b64_tr_b16 %7, %21 offset:96\n\t"
              "ds_read_b64_tr_b16 %8, %21 offset:576\n\tds_read_b64_tr_b16 %9, %21 offset:608\n\tds_read_b64_tr_b16 %10, %21 offset:640\n\tds_read_b64_tr_b16 %11, %21 offset:672\n\t"
              "ds_read_b64_tr_b16 %12, %21 offset:4608\n\tds_read_b64_tr_b16 %13, %21 offset:4640\n\tds_read_b64_tr_b16 %14, %21 offset:4672\n\tds_read_b64_tr_b16 %15, %21 offset:4704\n\t"
              "ds_read_b64_tr_b16 %16, %21 offset:5184\n\tds_read_b64_tr_b16 %17, %21 offset:5216\n\tds_read_b64_tr_b16 %18, %21 offset:5248\n\tds_read_b64_tr_b16 %19, %21 offset:5280"
              : "=&v"(k00), "=&v"(k01), "=&v"(k10), "=&v"(k11), "=&v"(a0), "=&v"(a1), "=&v"(a2), "=&v"(a3), "=&v"(b0), "=&v"(b1), "=&v"(b2), "=&v"(b3),
                "=&v"(c0), "=&v"(c1), "=&v"(c2), "=&v"(c3), "=&v"(d0), "=&v"(d1), "=&v"(d2), "=&v"(d3)
              : "v"(kaddr), "v"(vaddr) : "memory");
        { bf16x8 kf[4], qa[4], qb[4];
#pragma unroll
          for (int ks = 0; ks < 4; ++ks) { kf[ks] = frag_row(lds + KS, 272, 16 * jt, 32 * ks, idx, g); qa[ks] = frag_row(lds + qs, 272, 16 * it0, 32 * ks, idx, g); qb[ks] = frag_row(lds + qs, 272, 16 * it0 + 16, 32 * ks, idx, g); }
          asm volatile("s_waitcnt lgkmcnt(0)" : "+v"(k00), "+v"(k01), "+v"(k10), "+v"(k11), "+v"(a0), "+v"(a1), "+v"(a2), "+v"(a3), "+v"(b0), "+v"(b1), "+v"(b2), "+v"(b3),
                       "+v"(c0), "+v"(c1), "+v"(c2), "+v"(c3), "+v"(d0), "+v"(d1), "+v"(d2), "+v"(d3) :: "memory");
          f32x4 aa = {0.f, 0.f, 0.f, 0.f}, ab = aa;
#pragma unroll
          for (int ks = 0; ks < 4; ++ks) { aa = mfma16(kf[ks], qa[ks], aa); ab = mfma16(kf[ks], qb[ks], ab); }
          const int j0 = 16 * jt + 4 * g, ia = 16 * it0 + idx, ib = ia + 16;
#pragma unroll
          for (int r = 0; r < 4; ++r) { aa[r] = (j0 + r <= ia) ? aa[r] : 0.f; ab[r] = (j0 + r <= ib) ? ab[r] : 0.f; }
          u32x2 wa, wb; wa.x = cvt_pk_bf16(aa[0], aa[1]); wa.y = cvt_pk_bf16(aa[2], aa[3]); wb.x = cvt_pk_bf16(ab[0], ab[1]); wb.y = cvt_pk_bf16(ab[2], ab[3]);
          *(LAS u32x2*)(lds + AS + ia * 144 + j0 * 2) = wa; *(LAS u32x2*)(lds + AS + ib * 144 + j0 * 2) = wb; }
        {
          bf16x8 ka0, ka1, v0[4], v1[4];
          MKF(ka0, k00, k01) MKF(ka1, k10, k11)
          MKF(v0[0], a0, b0) MKF(v0[1], a1, b1) MKF(v0[2], a2, b2) MKF(v0[3], a3, b3)
          MKF(v1[0], c0, d0) MKF(v1[1], c1, d1) MKF(v1[2], c2, d2) MKF(v1[3], c3, d3)
#pragma unroll
          for (int dvt = 0; dvt < 4; ++dvt) { S[dvt] = mfma16(ka0, v0[dvt], S[dvt]); S[dvt] = mfma16(ka1, v1[dvt], S[dvt]); S[dvt] = S[dvt] * dc; }
#pragma unroll
          for (int dvt = 0; dvt < 4; ++dvt) { u32x2 wv; wv.x = cvt_pk_bf16(S[dvt][0], S[dvt][1]); wv.y = cvt_pk_bf16(S[dvt][2], S[dvt][3]);
              *(LAS u32x2*)(lds + stn + (16 * dvt + idx) * 272 + (16 * w + 4 * g) * 2) = wv; } }
        LDS_BARRIER();
        { const unsigned va = lbase + vs + (unsigned)((8 * g + (idx >> 2)) * 144 + (16 * jt + 4 * (idx & 3)) * 2);
          s16x4 x0, x1, y0, y1;
          asm volatile("ds_read_b64_tr_b16 %0, %4\n\tds_read_b64_tr_b16 %1, %4 offset:576\n\tds_read_b64_tr_b16 %2, %4 offset:4608\n\tds_read_b64_tr_b16 %3, %4 offset:5184"
                       : "=&v"(x0), "=&v"(x1), "=&v"(y0), "=&v"(y1) : "v"(va) : "memory");
          bf16x8 sf[4], qa[4], qb[4], a0f[2], a1f[2];
#pragma unroll
          for (int ks = 0; ks < 4; ++ks) { sf[ks] = frag_row(lds + stc, 272, 16 * jt, 32 * ks, idx, g); qa[ks] = frag_row(lds + qs, 272, 16 * it0, 32 * ks, idx, g); qb[ks] = frag_row(lds + qs, 272, 16 * it0 + 16, 32 * ks, idx, g); }
#pragma unroll
          for (int ks = 0; ks < 2; ++ks) { a0f[ks] = frag_row(lds + AS, 144, 16 * it0, 32 * ks, idx, g); a1f[ks] = frag_row(lds + AS, 144, 16 * it0 + 16, 32 * ks, idx, g); }
          asm volatile("s_waitcnt lgkmcnt(0)" : "+v"(x0), "+v"(x1), "+v"(y0), "+v"(y1) :: "memory");
          bf16x8 vf0, vf1;
          MKF(vf0, x0, x1) MKF(vf1, y0, y1)
          f32x4 oa = {0.f, 0.f, 0.f, 0.f}, ob = oa;
          oa = mfma16(vf0, a0f[0], oa); ob = mfma16(vf0, a1f[0], ob); oa = mfma16(vf1, a0f[1], oa); ob = mfma16(vf1, a1f[1], ob);
#pragma unroll
          for (int ks = 0; ks < 4; ++ks) { oa = mfma16(sf[ks], qa[ks], oa); ob = mfma16(sf[ks], qb[ks], ob); }
          u32x2 wa, wb; wa.x = cvt_pk_bf16(oa[0], oa[1]); wa.y = cvt_pk_bf16(oa[2], oa[3]); wb.x = cvt_pk_bf16(ob[0], ob[1]); wb.y = cvt_pk_bf16(ob[2], ob[3]);
          bf16_t* op = og + (size_t)(b * SEQ + n * 64 + 16 * it0 + idx) * 1024 + hh * 256 + sl * 64 + 16 * jt + 4 * g;
          *(u32x2*)op = wa; *(u32x2*)(op + 16 * 1024) = wb; }
      }
    }
    asm volatile("s_waitcnt vmcnt(0)" ::: "memory");
    __syncthreads();
}
#undef MKF

__device__ void wt_fill(const Params& p, unsigned* ctr, unsigned char* smem_g, LAS unsigned char* lds) {
    constexpr int LD = 260, NT = 768;
    float* tile = (float*)smem_g;
    const int tid = opaque_tid();
    if (tid == 0) *(LAS int*)(lds + LDS_SLOT) = (int)atomicAdd(ctr, 1u);
    __syncthreads();
    int j = *(LAS int*)(lds + LDS_SLOT);
    __syncthreads();
    if (j >= NT) return;
    WtDesc cur = (j < 768) ? wt_decode(p, 0, j < 512 ? 768 + j : 1792 + (j - 512)) : wt_decode(p, 1, j - 768);
    f32x4 v[8];
    wt_load(cur, tid, v);
    for (;;) {
        if (tid == 0) *(LAS int*)(lds + LDS_SLOT) = (int)atomicAdd(ctr, 1u);
        { const int r = tid >> 6, c4 = tid & 63;
#pragma unroll
          for (int i = 0; i < 8; ++i) *(f32x4*)(tile + (r + 8 * i) * LD + 4 * c4) = v[i]; }
        LDS_BARRIER();
        const int nj = *(LAS int*)(lds + LDS_SLOT); const bool has = nj < NT;
        WtDesc nd = cur;
        if (has) { nd = (nj < 768) ? wt_decode(p, 0, nj < 512 ? 768 + nj : 1792 + (nj - 512)) : wt_decode(p, 1, nj - 768); wt_load(nd, tid, v); }
        { const int n = tid >> 1, kh = tid & 1;
#pragma unroll
          for (int q = 0; q < 4; ++q) {
              float e[8];
#pragma unroll
              for (int jj = 0; jj < 8; ++jj) e[jj] = tile[(32 * kh + 8 * q + jj) * LD + n];
              u32x4 w; w.x = cvt_pk_bf16(e[0], e[1]); w.y = cvt_pk_bf16(e[2], e[3]); w.z = cvt_pk_bf16(e[4], e[5]); w.w = cvt_pk_bf16(e[6], e[7]);
              *(u32x4*)(cur.Bt + (size_t)(cur.n0dst + n) * cur.K + cur.k0 + 32 * kh + 8 * q) = w;
          } }
        LDS_BARRIER();
        if (!has) break;
        cur = nd;
    }
    asm volatile("s_waitcnt vmcnt(0)" ::: "memory");
    __syncthreads();
}

__device__ __forceinline__ void dil_preload(const Params& p, int item, int tid, u32x4 (&pk)[8], u32x4 (&pv)[8]) {
    const int pat = item >> 10, rem = item & 1023, b = rem >> 8, head = (rem >> 5) & 7, sb = rem & 31;
    const int dsh = pat * 2, nbsh = 5 - dsh;
    const int r = sb >> nbsh, blk = sb & ((1 << nbsh) - 1);
    const bf16_t* hb = (const bf16_t*)(p.ws + OFF_H) + (size_t)(b * SEQ) * HC;
    const int piece = tid & 15;
#pragma unroll
    for (int it = 0; it < 8; ++it) {
        const int row = (tid >> 4) + 32 * it, lj = (blk - 1) * 128 + row;
        u32x4 kv = {0u, 0u, 0u, 0u}, vv = kv;
        if (lj >= 0) { const int pos = r + (lj << dsh); const bf16_t* rp = hb + (size_t)pos * HC + head * 128 + piece * 8; kv = *(const u32x4*)(rp + 4096); vv = *(const u32x4*)(rp + 5120); }
        pk[it] = kv; pv[it] = vv;
    }
}
__device__ __forceinline__ void dilated_item(const Params& p, int item, int next, u32x4 (&pk)[8], u32x4 (&pv)[8], LAS unsigned char* lds) {
    const int tid = opaque_tid(), lane = tid & 63, w = __builtin_amdgcn_readfirstlane(tid >> 6), idx = lane & 15, g = lane >> 4;
    const int pat = item >> 10, rem = item & 1023, b = rem >> 8, head = (rem >> 5) & 7, sb = rem & 31;
    const int dsh = pat * 2, nbsh = 5 - dsh;
    const int r = sb >> nbsh, blk = sb & ((1 << nbsh) - 1);
    unsigned char* ws = p.ws;
    const bf16_t* hb = (const bf16_t*)(ws + OFF_H) + (size_t)(b * SEQ) * HC;
    const unsigned lbase = (unsigned)(size_t)lds;
    { const int piece = tid & 15;
#pragma unroll
      for (int it = 0; it < 8; ++it) { const int row = (tid >> 4) + 32 * it;
          *(LAS u32x4*)(lds + row * KV_STRIDE + piece * 16) = pk[it]; *(LAS u32x4*)(lds + KV_BUF + row * KV_STRIDE + piece * 16) = pv[it]; } }
    const int qpos = r + ((blk * 128 + 16 * w + idx) << dsh);
    bf16x8 qf[4];
    { const bf16_t* qp = hb + (size_t)qpos * HC + 3072 + head * 128 + 8 * g;
#pragma unroll
      for (int ks = 0; ks < 4; ++ks) qf[ks] = *(const bf16x8*)(qp + 32 * ks); }
    if (next < 3072) dil_preload(p, next, tid, pk, pv);
    LDS_BARRIER();
    f32x4 sc[9];
#pragma unroll
    for (int tt = 0; tt < 9; ++tt) {
        sc[tt] = (f32x4){0.f, 0.f, 0.f, 0.f};
#pragma unroll
        for (int ks = 0; ks < 4; ++ks) sc[tt] = mfma16(frag_row(lds, KV_STRIDE, 16 * (w + tt), 32 * ks, idx, g), qf[ks], sc[tt]);
    }
    const int qi = 128 + 16 * w + idx;
    float mx = -1e30f;
#pragma unroll
    for (int tt = 0; tt < 9; ++tt)
#pragma unroll
        for (int rr = 0; rr < 4; ++rr) {
            const int kj = 16 * (w + tt) + 4 * g + rr, diff = qi - kj;
            const bool valid = (diff >= 0) && (diff <= 128) && (blk > 0 || kj >= 128);
            const float s = valid ? sc[tt][rr] * LOG2E : -1e30f;
            sc[tt][rr] = s; mx = fmaxf(mx, s);
        }
    mx = fmaxf(mx, __shfl_xor(mx, 16)); mx = fmaxf(mx, __shfl_xor(mx, 32));
    float sum = 0.f;
#pragma unroll
    for (int tt = 0; tt < 9; ++tt)
#pragma unroll
        for (int rr = 0; rr < 4; ++rr) { const float e = fexp2(sc[tt][rr] - mx); sc[tt][rr] = e; sum += e; }
    sum += __shfl_xor(sum, 16); sum += __shfl_xor(sum, 32);
    f32x4 ot[8];
#pragma unroll
    for (int c = 0; c < 8; ++c) ot[c] = (f32x4){0.f, 0.f, 0.f, 0.f};
#pragma unroll
    for (int s5 = 0; s5 < 5; ++s5) {
        const int ta = w + 2 * s5, tb = (s5 < 4) ? ta + 1 : ta;
        u32x4 pw; pw.x = cvt_pk_bf16(sc[2 * s5][0], sc[2 * s5][1]); pw.y = cvt_pk_bf16(sc[2 * s5][2], sc[2 * s5][3]);
        if (s5 < 4) { pw.z = cvt_pk_bf16(sc[(2 * s5 + 1) % 9][0], sc[(2 * s5 + 1) % 9][1]); pw.w = cvt_pk_bf16(sc[(2 * s5 + 1) % 9][2], sc[(2 * s5 + 1) % 9][3]); } else { pw.z = 0u; pw.w = 0u; }
        const bf16x8 pf = __builtin_bit_cast(bf16x8, pw);
        const unsigned aA = lbase + KV_BUF + (unsigned)((16 * ta + 4 * g + (idx >> 2)) * KV_STRIDE + 8 * (idx & 3));
        const unsigned aB = lbase + KV_BUF + (unsigned)((16 * tb + 4 * g + (idx >> 2)) * KV_STRIDE + 8 * (idx & 3));
        bf16x8 vf[4];
        tr_frag4(aA, aB, vf);
#pragma unroll
        for (int c = 0; c < 4; ++c) ot[c] = mfma16(vf[c], pf, ot[c]);
        tr_frag4(aA + 128, aB + 128, vf);
#pragma unroll
        for (int c = 0; c < 4; ++c) ot[4 + c] = mfma16(vf[c], pf, ot[4 + c]);
    }
    const float inv = 1.0f / sum;
    const size_t tok = (size_t)(b * SEQ + qpos);
    bf16_t* od = (bf16_t*)(ws + (pat == 0 ? OFF_B2 : (pat == 1 ? OFF_B2 + 32 * MiB : OFF_OD2)));
#pragma unroll
    for (int c = 0; c < 8; ++c) { u32x2 wv; wv.x = cvt_pk_bf16(ot[c][0] * inv, ot[c][1] * inv); wv.y = cvt_pk_bf16(ot[c][2] * inv, ot[c][3] * inv);
        *(u32x2*)(od + tok * 1024 + head * 128 + 16 * c + 4 * g) = wv; }
    if (g == 0) ((float*)(ws + OFF_LSE))[(size_t)pat * T_TOK * 8 + tok * 8 + head] = (mx + flog2(sum)) * LN2;
    LDS_BARRIER();
}

__device__ void cross_items(const Params& p, LAS unsigned char* lds) {
    const int tid = opaque_tid(), lane = tid & 63, w = __builtin_amdgcn_readfirstlane(tid >> 6), idx = lane & 15, g = lane >> 4;
    unsigned char* ws = p.ws;
    bf16_t* oc = (bf16_t*)(ws + OFF_OC);
    const unsigned lbase = (unsigned)(size_t)lds;
    const int piece = tid & 15, srow = tid >> 4;
    const int G = (int)gridDim.x;
    u32x4 pre[8];
#define XLOAD(kvbase, c8) do { const bf16_t* _src = (kvbase) + (((c8) >= 4) ? 2048 : 0) + ((c8) & 3) * 128 + piece * 8; \
        _Pragma("unroll") for (int _it = 0; _it < 8; ++_it) pre[_it] = *(const u32x4*)(_src + (size_t)(srow + 32 * _it) * 4096); } while (0)
#define XSTORE(buf) do { _Pragma("unroll") for (int _it = 0; _it < 8; ++_it) *(LAS u32x4*)((buf) + (srow + 32 * _it) * KV_STRIDE + piece * 16) = pre[_it]; } while (0)
    const int pmx = 8 * ((int)blockIdx.x & 7) + ((int)blockIdx.x >> 5), hdx = ((int)blockIdx.x >> 3) & 3;
    const int item0 = (pmx >> 4) * 128 + hdx * 32 + 2 * (pmx & 15);
    { const bf16_t* kvb0 = (const bf16_t*)(ws + OFF_MKV) + (size_t)((item0 >> 7) * 256) * 4096 + ((item0 >> 5) & 3) * 512; XLOAD(kvb0, 0); }
    for (int item = item0; item < item0 + 2; ++item) {
        const int b = item >> 7, head = (item >> 5) & 3, qb = item & 31;
        const size_t tok = (size_t)(b * SEQ + qb * 128 + 16 * w + idx);
        const bf16_t* qrow = (const bf16_t*)(ws + OFF_B1) + tok * DM + head * 512 + 8 * g;
        const bf16_t* kvb = (const bf16_t*)(ws + OFF_MKV) + (size_t)(b * 256) * 4096 + head * 512;
        f32x4 sc[16];
#pragma unroll
        for (int kt = 0; kt < 16; ++kt) sc[kt] = (f32x4){0.f, 0.f, 0.f, 0.f};
        for (int c = 0; c < 4; ++c) {
            LAS unsigned char* buf = lds + (c & 1) * KV_BUF;
            XSTORE(buf);
            bf16x8 qf[4];
#pragma unroll
            for (int ks = 0; ks < 4; ++ks) qf[ks] = *(const bf16x8*)(qrow + c * 128 + 32 * ks);
            XLOAD(kvb, c + 1);
            LDS_BARRIER();
#pragma unroll
            for (int kt = 0; kt < 16; ++kt)
#pragma unroll
                for (int ks = 0; ks < 4; ++ks) sc[kt] = mfma16(frag_row(buf, KV_STRIDE, 16 * kt, 32 * ks, idx, g), qf[ks], sc[kt]);
        }
        const float scl = 0.04419417382415922f * LOG2E;
        float mx = -1e30f;
#pragma unroll
        for (int kt = 0; kt < 16; ++kt)
#pragma unroll
            for (int rr = 0; rr < 4; ++rr) { const float sv = sc[kt][rr] * scl; sc[kt][rr] = sv; mx = fmaxf(mx, sv); }
        mx = fmaxf(mx, __shfl_xor(mx, 16)); mx = fmaxf(mx, __shfl_xor(mx, 32));
        float sum = 0.f;
#pragma unroll
        for (int kt = 0; kt < 16; ++kt)
#pragma unroll
            for (int rr = 0; rr < 4; ++rr) { const float e = fexp2(sc[kt][rr] - mx); sc[kt][rr] = e; sum += e; }
        sum += __shfl_xor(sum, 16); sum += __shfl_xor(sum, 32);
        const float inv = 1.0f / sum;
        bf16x8 pf[8];
#pragma unroll
        for (int sx = 0; sx < 8; ++sx) { u32x4 pw; pw.x = cvt_pk_bf16(sc[2 * sx][0], sc[2 * sx][1]); pw.y = cvt_pk_bf16(sc[2 * sx][2], sc[2 * sx][3]); pw.z = cvt_pk_bf16(sc[2 * sx + 1][0], sc[2 * sx + 1][1]); pw.w = cvt_pk_bf16(sc[2 * sx + 1][2], sc[2 * sx + 1][3]);
            pf[sx] = __builtin_bit_cast(bf16x8, pw); }
        const int nitem = (item + 1 < item0 + 2) ? item + 1 : 512;
        const bf16_t* nkvb = (const bf16_t*)(ws + OFF_MKV) + (size_t)(((nitem < 512 ? nitem : item) >> 7) * 256) * 4096 + (((nitem < 512 ? nitem : item) >> 5) & 3) * 512;
        for (int c = 0; c < 4; ++c) {
            LAS unsigned char* buf = lds + (c & 1) * KV_BUF;
            XSTORE(buf);
            if (c < 3) XLOAD(kvb, 5 + c); else XLOAD(nkvb, 0);
            LDS_BARRIER();
            f32x4 ot[8];
#pragma unroll
            for (int c8 = 0; c8 < 8; ++c8) ot[c8] = (f32x4){0.f, 0.f, 0.f, 0.f};
            const unsigned bb = lbase + (unsigned)((c & 1) * KV_BUF);
#pragma unroll
            for (int sx = 0; sx < 8; ++sx) {
                const unsigned aA = bb + (unsigned)((32 * sx + 4 * g + (idx >> 2)) * KV_STRIDE + 8 * (idx & 3));
                const unsigned aB = aA + 16u * KV_STRIDE;
                bf16x8 vf[4];
                tr_frag4(aA, aB, vf);
#pragma unroll
                for (int c8 = 0; c8 < 4; ++c8) ot[c8] = mfma16(vf[c8], pf[sx], ot[c8]);
                tr_frag4(aA + 128, aB + 128, vf);
#pragma unroll
                for (int c8 = 0; c8 < 4; ++c8) ot[4 + c8] = mfma16(vf[c8], pf[sx], ot[4 + c8]);
            }
#pragma unroll
            for (int c8 = 0; c8 < 8; ++c8) { u32x2 wv; wv.x = cvt_pk_bf16(ot[c8][0] * inv, ot[c8][1] * inv); wv.y = cvt_pk_bf16(ot[c8][2] * inv, ot[c8][3] * inv);
                *(u32x2*)(oc + tok * DM + head * 512 + c * 128 + 16 * c8 + 4 * g) = wv; }
        }
    }
#undef XLOAD
#undef XSTORE
    asm volatile("s_waitcnt vmcnt(0)" ::: "memory");
    __syncthreads();
}

__device__ void merge_phase(const Params& p) {
    const int tid_ = opaque_tid(); const int lane = tid_ & 63, wid = tid_ >> 6;
    unsigned char* ws = p.ws;
    const bf16_t* og = (const bf16_t*)(ws + OFF_OG); const bf16_t* h = (const bf16_t*)(ws + OFF_H);
    const bf16_t* od0 = (const bf16_t*)(ws + OFF_B2); const bf16_t* od1 = (const bf16_t*)(ws + OFF_B2 + 32 * MiB); const bf16_t* od2 = (const bf16_t*)(ws + OFF_OD2);
    const float* lse = (const float*)(ws + OFF_LSE);
    bf16_t* mix = (bf16_t*)(ws + OFF_B1);
    for (int tok = blockIdx.x * 8 + wid; tok < T_TOK; tok += gridDim.x * 8) {
        { const int hh = lane >> 4, sub = lane & 15;
          const bf16_t* src = og + (size_t)tok * 1024 + hh * 256 + sub * 16;
          const u32x4 a = *(const u32x4*)src, b = *(const u32x4*)(src + 8);
          float xv[16];
#pragma unroll
          for (int j = 0; j < 4; ++j) { xv[2 * j] = bflo(a[j]); xv[2 * j + 1] = bfhi(a[j]); xv[8 + 2 * j] = bflo(b[j]); xv[8 + 2 * j + 1] = bfhi(b[j]); }
          float s = 0.f;
#pragma unroll
          for (int j = 0; j < 16; ++j) s += xv[j];
          s += __shfl_xor(s, 1); s += __shfl_xor(s, 2); s += __shfl_xor(s, 4); s += __shfl_xor(s, 8);
          const float mean = s * (1.0f / 256.0f);
          float q = 0.f;
#pragma unroll
          for (int j = 0; j < 16; ++j) { const float dlt = xv[j] - mean; q += dlt * dlt; }
          q += __shfl_xor(q, 1); q += __shfl_xor(q, 2); q += __shfl_xor(q, 4); q += __shfl_xor(q, 8);
          const float rstd = rsqrtf(q * (1.0f / 256.0f) + 1e-5f);
          const bf16_t* rgp = h + (size_t)tok * HC + 2048 + hh * 256 + sub * 16;
          const u32x4 ra = *(const u32x4*)rgp, rb = *(const u32x4*)(rgp + 8);
          const float* ngp = p.norm_g + hh * 256 + sub * 16;
          float ov[16];
#pragma unroll
          for (int j4 = 0; j4 < 4; ++j4) { const f32x4 ng = *(const f32x4*)(ngp + 4 * j4);
#pragma unroll
              for (int j = 0; j < 4; ++j) { const int e = 4 * j4 + j; const unsigned rw = (e < 8) ? ra[e >> 1] : rb[(e - 8) >> 1]; const float rv = (e & 1) ? bfhi(rw) : bflo(rw);
                  ov[e] = (xv[e] - mean) * rstd * ng[j] * silu_f(rv); } }
          u32x4 o0, o1;
#pragma unroll
          for (int j = 0; j < 4; ++j) { o0[j] = cvt_pk_bf16(ov[2 * j], ov[2 * j + 1]); o1[j] = cvt_pk_bf16(ov[8 + 2 * j], ov[8 + 2 * j + 1]); }
          bf16_t* dst = mix + (size_t)tok * DM + hh * 256 + sub * 16;
          *(u32x4*)dst = o0; *(u32x4*)(dst + 8) = o1; }
        { const int hd = lane >> 3, sub = lane & 7;
          const float l0 = lse[(size_t)tok * 8 + hd], l1 = lse[(size_t)T_TOK * 8 + (size_t)tok * 8 + hd], l2 = lse[(size_t)2 * T_TOK * 8 + (size_t)tok * 8 + hd];
          const float m = fmaxf(l0, fmaxf(l1, l2));
          float e0 = fexp2((l0 - m) * LOG2E), e1 = fexp2((l1 - m) * LOG2E), e2 = fexp2((l2 - m) * LOG2E);
          const float inv = 1.0f / (e0 + e1 + e2); e0 *= inv; e1 *= inv; e2 *= inv;
          const size_t so = (size_t)tok * 1024 + hd * 128 + sub * 16;
          u32x4 o[2];
#pragma unroll
          for (int hf = 0; hf < 2; ++hf) { const u32x4 a = *(const u32x4*)(od0 + so + 8 * hf), b = *(const u32x4*)(od1 + so + 8 * hf), c = *(const u32x4*)(od2 + so + 8 * hf);
#pragma unroll
              for (int j = 0; j < 4; ++j) o[hf][j] = cvt_pk_bf16(e0 * bflo(a[j]) + e1 * bflo(b[j]) + e2 * bflo(c[j]), e0 * bfhi(a[j]) + e1 * bfhi(b[j]) + e2 * bfhi(c[j])); }
          bf16_t* dst = mix + (size_t)tok * DM + 1024 + hd * 128 + sub * 16;
          *(u32x4*)dst = o[0]; *(u32x4*)(dst + 8) = o[1]; }
    }
}

__device__ void ln_phase(float* io, const float* __restrict__ gam, const float* __restrict__ bet, bf16_t* ob) {
    const int tid_ = opaque_tid(); const int lane = tid_ & 63, wid = tid_ >> 6;
    for (int row = blockIdx.x * 8 + wid; row < T_TOK; row += gridDim.x * 8) {
        float* pr = io + (size_t)row * DM + lane * 4;
        f32x4 v[8]; float s = 0.f;
#pragma unroll
        for (int j = 0; j < 8; ++j) { v[j] = *(const f32x4*)(pr + 256 * j); s += (v[j][0] + v[j][1]) + (v[j][2] + v[j][3]); }
#pragma unroll
        for (int o = 32; o; o >>= 1) s += __shfl_xor(s, o);
        const float mean = s * (1.0f / 2048.0f);
        float q = 0.f;
#pragma unroll
        for (int j = 0; j < 8; ++j) { const f32x4 dlt = v[j] - mean; q += (dlt[0] * dlt[0] + dlt[1] * dlt[1]) + (dlt[2] * dlt[2] + dlt[3] * dlt[3]); }
#pragma unroll
        for (int o = 32; o; o >>= 1) q += __shfl_xor(q, o);
        const float rstd = rsqrtf(q * (1.0f / 2048.0f) + 1e-5f);
#pragma unroll
        for (int j = 0; j < 8; ++j) {
            const f32x4 gv = *(const f32x4*)(gam + lane * 4 + 256 * j), bv = *(const f32x4*)(bet + lane * 4 + 256 * j);
            const f32x4 y = (v[j] - mean) * rstd * gv + bv;
            if (!ob) *(f32x4*)(pr + 256 * j) = y;
            if (ob) { u32x2 wv; wv.x = cvt_pk_bf16(y[0], y[1]); wv.y = cvt_pk_bf16(y[2], y[3]); *(u32x2*)(ob + (size_t)row * DM + lane * 4 + 256 * j) = wv; }
        }
    }
}


__device__ void ln_phase2(const bf16_t* __restrict__ mix, const float* __restrict__ Rf, const bf16_t* __restrict__ Rb, const float* __restrict__ gam, const float* __restrict__ bet, bf16_t* ob, float* of) {
    const int tid_ = opaque_tid(); const int lane = tid_ & 63, wid = tid_ >> 6;
    for (int row = blockIdx.x * 8 + wid; row < T_TOK; row += gridDim.x * 8) {
        const size_t ro = (size_t)row * DM + lane * 8;
        float v[32]; float s = 0.f;
#pragma unroll
        for (int j = 0; j < 4; ++j) {
            const u32x4 m = *(const u32x4*)(mix + ro + 512 * j);
            float r[8];
            if (Rf) { const f32x4 a = *(const f32x4*)(Rf + ro + 512 * j), b = *(const f32x4*)(Rf + ro + 512 * j + 4);
                r[0] = a[0]; r[1] = a[1]; r[2] = a[2]; r[3] = a[3]; r[4] = b[0]; r[5] = b[1]; r[6] = b[2]; r[7] = b[3]; }
            else { const u32x4 rb = *(const u32x4*)(Rb + ro + 512 * j);
                r[0] = bflo(rb.x); r[1] = bfhi(rb.x); r[2] = bflo(rb.y); r[3] = bfhi(rb.y); r[4] = bflo(rb.z); r[5] = bfhi(rb.z); r[6] = bflo(rb.w); r[7] = bfhi(rb.w); }
            v[8 * j + 0] = DN_ALPHA * r[0] + bflo(m.x); v[8 * j + 1] = DN_ALPHA * r[1] + bfhi(m.x); v[8 * j + 2] = DN_ALPHA * r[2] + bflo(m.y); v[8 * j + 3] = DN_ALPHA * r[3] + bfhi(m.y);
            v[8 * j + 4] = DN_ALPHA * r[4] + bflo(m.z); v[8 * j + 5] = DN_ALPHA * r[5] + bfhi(m.z); v[8 * j + 6] = DN_ALPHA * r[6] + bflo(m.w); v[8 * j + 7] = DN_ALPHA * r[7] + bfhi(m.w);
#pragma unroll
            for (int e = 0; e < 8; ++e) s += v[8 * j + e];
        }
#pragma unroll
        for (int o = 32; o; o >>= 1) s += __shfl_xor(s, o);
        const float mean = s * (1.0f / 2048.0f);
        float q = 0.f;
#pragma unroll
        for (int e = 0; e < 32; ++e) { const float dlt = v[e] - mean; q += dlt * dlt; }
#pragma unroll
        for (int o = 32; o; o >>= 1) q += __shfl_xor(q, o);
        const float rstd = rsqrtf(q * (1.0f / 2048.0f) + 1e-5f);
#pragma unroll
        for (int j = 0; j < 4; ++j) {
            const f32x4 g0 = *(const f32x4*)(gam + lane * 8 + 512 * j), g1 = *(const f32x4*)(gam + lane * 8 + 512 * j + 4);
            const f32x4 b0 = *(const f32x4*)(bet + lane * 8 + 512 * j), b1 = *(const f32x4*)(bet + lane * 8 + 512 * j + 4);
            f32x4 y0, y1;
#pragma unroll
            for (int e = 0; e < 4; ++e) { y0[e] = (v[8 * j + e] - mean) * rstd * g0[e] + b0[e]; y1[e] = (v[8 * j + 4 + e] - mean) * rstd * g1[e] + b1[e]; }
            if (ob) { u32x4 w; w.x = cvt_pk_bf16(y0[0], y0[1]); w.y = cvt_pk_bf16(y0[2], y0[3]); w.z = cvt_pk_bf16(y1[0], y1[1]); w.w = cvt_pk_bf16(y1[2], y1[3]); *(u32x4*)(ob + ro + 512 * j) = w; }
            else { *(f32x4*)(of + ro + 512 * j) = y0; *(f32x4*)(of + ro + 512 * j + 4) = y1; }
        }
    }
}

__device__ void conv_phase(const Params& p, int half) {
    unsigned char* ws = p.ws;
    const bf16_t* u = (const bf16_t*)(ws + OFF_U); bf16_t* gout = (bf16_t*)(ws + OFF_G);
    constexpr int NCG = DFF / 8;
    for (int task = blockIdx.x * 512 + opaque_tid(); task < 512 * NCG; task += gridDim.x * 512) {
        const int cgp = task % NCG, tb = task / NCG, c = cgp * 8, r0 = tb * 16, t0 = half * 8192 + r0;
        float wg[3][8], wu[3][8], bg[8], bu[8];
#pragma unroll
        for (int i = 0; i < 3; ++i)
#pragma unroll
            for (int j4 = 0; j4 < 2; ++j4) { const f32x4 a = *(const f32x4*)(p.conv_w + (size_t)i * 11008 + c + 4 * j4), b = *(const f32x4*)(p.conv_w + (size_t)i * 11008 + DFF + c + 4 * j4);
#pragma unroll
                for (int j = 0; j < 4; ++j) { wg[i][4 * j4 + j] = a[j]; wu[i][4 * j4 + j] = b[j]; } }
#pragma unroll
        for (int j4 = 0; j4 < 2; ++j4) { const f32x4 a = *(const f32x4*)(p.conv_b + c + 4 * j4), b = *(const f32x4*)(p.conv_b + DFF + c + 4 * j4);
#pragma unroll
            for (int j = 0; j < 4; ++j) { bg[4 * j4 + j] = a[j]; bu[4 * j4 + j] = b[j]; } }
        float g2[8], g1[8], u2[8], u1[8];
        if ((t0 & (SEQ - 1)) == 0) {
#pragma unroll
            for (int j = 0; j < 8; ++j) { g2[j] = 0.f; g1[j] = 0.f; u2[j] = 0.f; u1[j] = 0.f; }
        } else {
            const u32x4 a2 = *(const u32x4*)(u + (size_t)(r0 - 2) * 11008 + c), a1 = *(const u32x4*)(u + (size_t)(r0 - 1) * 11008 + c);
            const u32x4 b2 = *(const u32x4*)(u + (size_t)(r0 - 2) * 11008 + DFF + c), b1 = *(const u32x4*)(u + (size_t)(r0 - 1) * 11008 + DFF + c);
#pragma unroll
            for (int j = 0; j < 4; ++j) { g2[2 * j] = bflo(a2[j]); g2[2 * j + 1] = bfhi(a2[j]); g1[2 * j] = bflo(a1[j]); g1[2 * j + 1] = bfhi(a1[j]);
                u2[2 * j] = bflo(b2[j]); u2[2 * j + 1] = bfhi(b2[j]); u1[2 * j] = bflo(b1[j]); u1[2 * j + 1] = bfhi(b1[j]); }
        }
#pragma unroll 2
        for (int rr = 0; rr < 16; ++rr) {
            const u32x4 a0 = *(const u32x4*)(u + (size_t)(r0 + rr) * 11008 + c), b0 = *(const u32x4*)(u + (size_t)(r0 + rr) * 11008 + DFF + c);
            float gc[8], uc[8], res[8];
#pragma unroll
            for (int j = 0; j < 4; ++j) { gc[2 * j] = bflo(a0[j]); gc[2 * j + 1] = bfhi(a0[j]); uc[2 * j] = bflo(b0[j]); uc[2 * j + 1] = bfhi(b0[j]); }
#pragma unroll
            for (int j = 0; j < 8; ++j) {
                const float yg = bg[j] + wg[0][j] * g2[j] + wg[1][j] * g1[j] + wg[2][j] * gc[j];
                const float yu = bu[j] + wu[0][j] * u2[j] + wu[1][j] * u1[j] + wu[2][j] * uc[j];
                res[j] = silu_f(yg) * yu;
                g2[j] = g1[j]; g1[j] = gc[j]; u2[j] = u1[j]; u1[j] = uc[j];
            }
            u32x4 o; o.x = cvt_pk_bf16(res[0], res[1]); o.y = cvt_pk_bf16(res[2], res[3]); o.z = cvt_pk_bf16(res[4], res[5]); o.w = cvt_pk_bf16(res[6], res[7]);
            *(u32x4*)(gout + (size_t)(t0 + rr) * DFF + c) = o;
        }
    }
}


__device__ void conv_fixup(const Params& p) {
    unsigned char* ws = p.ws;
    const float* hu = (const float*)(ws + OFF_U); bf16_t* gout = (bf16_t*)(ws + OFF_G);
    for (int task = blockIdx.x * 512 + opaque_tid(); task < 128 * DFF; task += gridDim.x * 512) {
        const int bd = task / DFF, c = task - bd * DFF, pm = bd >> 1, hb = bd & 1;
        if (hb == 0 && (pm & 15) == 0) continue;
        const int rp = (hb == 0) ? ((pm - 1) * 8 + 6) : (pm * 8 + 2), rc = pm * 8 + 4 * hb;
        float ug[4], uu[4];
        ug[0] = hu[((size_t)((rp + 0) * 2 + 0)) * DFF + c]; ug[1] = hu[((size_t)((rp + 1) * 2 + 0)) * DFF + c];
        ug[2] = hu[((size_t)((rc + 0) * 2 + 0)) * DFF + c]; ug[3] = hu[((size_t)((rc + 1) * 2 + 0)) * DFF + c];
        uu[0] = hu[((size_t)((rp + 0) * 2 + 1)) * DFF + c]; uu[1] = hu[((size_t)((rp + 1) * 2 + 1)) * DFF + c];
        uu[2] = hu[((size_t)((rc + 0) * 2 + 1)) * DFF + c]; uu[3] = hu[((size_t)((rc + 1) * 2 + 1)) * DFF + c];
        const float wg0 = p.conv_w[c], wg1 = p.conv_w[11008 + c], wg2 = p.conv_w[22016 + c], wu0 = p.conv_w[DFF + c], wu1 = p.conv_w[11008 + DFF + c], wu2 = p.conv_w[22016 + DFF + c];
        const float bg = p.conv_b[c], bu = p.conv_b[DFF + c];
#pragma unroll
        for (int e = 0; e < 2; ++e) {
            const float yg = bg + wg0 * ug[e] + wg1 * ug[e + 1] + wg2 * ug[e + 2];
            const float yu = bu + wu0 * uu[e] + wu1 * uu[e + 1] + wu2 * uu[e + 2];
            const float r = silu_f(yg) * yu;
            gout[(size_t)(pm * 256 + 128 * hb + e) * DFF + c] = (bf16_t)(cvt_pk_bf16(r, r) & 0xffffu);
        }
    }
}

#define XB_TMO      128
#define XB_XCNT(j)  (256  + 64 * (j))
#define XB_XSUB(j)  (1280 + 64 * (j))
#define XB_XGEN(j)  (2304 + 64 * (j))
#define XB_TOP      3328
#define XB_TOPGEN   3392
#define XCD_BAR_WORDS 3456
#define XB_SPIN_CAP (1u << 22)
__device__ __forceinline__ unsigned xb_ld(unsigned* p)              { return __hip_atomic_load(p, __ATOMIC_RELAXED, __HIP_MEMORY_SCOPE_AGENT); }
__device__ __forceinline__ unsigned xb_add(unsigned* p, unsigned v) { return __hip_atomic_fetch_add(p, v, __ATOMIC_RELAXED, __HIP_MEMORY_SCOPE_AGENT); }
__device__ __forceinline__ unsigned xb_xcc_id() { return (unsigned)__builtin_amdgcn_s_getreg((3 << 11) | 20) & 0xFu; }
#define XB_SPIN(cond, bar) do { unsigned _sp = 0; while (cond) { __builtin_amdgcn_s_sleep(1); \
    if ((++_sp & 255u) == 0u) { if (xb_ld(&(bar)[XB_TMO])) break; if (_sp > XB_SPIN_CAP) { atomicAdd(&(bar)[XB_TMO], 1u); break; } } } } while (0)
struct XcdBarrier { unsigned* bar; unsigned x; volatile LAS unsigned* st; };
__device__ __forceinline__ XcdBarrier xcd_barrier_post(unsigned* bar, volatile LAS unsigned* st) {
    XcdBarrier b; b.bar = bar; b.x = xb_xcc_id(); b.st = st;
    if (threadIdx.x == 0) (void)xb_add(&bar[XB_XCNT(b.x)], 1u);
    return b;
}
__device__ __forceinline__ void xcd_barrier_complete(unsigned* bar, unsigned x, unsigned& nloc, unsigned& nx) {
    const unsigned G = gridDim.x * gridDim.y * gridDim.z;
    unsigned sum, cnt, mine, sp = 0u;
    for (;;) {
        sum = 0u; cnt = 0u; mine = 0u;
#pragma unroll
        for (unsigned j = 0; j < 16; ++j) { const unsigned c = xb_ld(&bar[XB_XCNT(j)]); sum += c; cnt += (c > 0u) ? 1u : 0u; mine = (j == x) ? c : mine; }
        if (sum == G) break;
        __builtin_amdgcn_s_sleep(1);
        if ((++sp & 255u) == 0u) { if (xb_ld(&bar[XB_TMO])) break; if (sp > XB_SPIN_CAP) { atomicAdd(&bar[XB_TMO], 1u); break; } }
    }
    nloc = mine > 0u ? mine : 1u; nx = cnt > 0u ? cnt : 1u;
}
__device__ __forceinline__ void xcd_barrier(const XcdBarrier& b) {
    asm volatile("s_waitcnt vmcnt(0)" ::: "memory");
    __syncthreads();
    if (threadIdx.x == 0) {
        unsigned* bar = b.bar;
        __builtin_amdgcn_s_waitcnt(0);
        unsigned nloc = b.st[0], nx = b.st[1];
        if (nloc == 0u) { xcd_barrier_complete(bar, b.x, nloc, nx); b.st[0] = nloc; b.st[1] = nx; }
        const unsigned old = xb_add(&bar[XB_XSUB(b.x)], 1u);
        const unsigned gen = old / nloc;
        if (old + 1u == (gen + 1u) * nloc) {
            __builtin_amdgcn_fence(__ATOMIC_RELEASE, "agent");
            asm volatile("s_waitcnt vmcnt(0)" ::: "memory");
            const unsigned og = xb_add(&bar[XB_TOP], 1u);
            const unsigned tg = og / nx;
            if (og + 1u == (tg + 1u) * nx) xb_add(&bar[XB_TOPGEN], 1u);
            else XB_SPIN(xb_ld(&bar[XB_TOPGEN]) == tg, bar);
            __builtin_amdgcn_fence(__ATOMIC_ACQUIRE, "agent");
            xb_add(&bar[XB_XGEN(b.x)], 1u);
            asm volatile("s_waitcnt vmcnt(0)" ::: "memory");
        } else {
            XB_SPIN(xb_ld(&bar[XB_XGEN(b.x)]) == gen, bar);
            __builtin_amdgcn_fence(__ATOMIC_ACQUIRE, "agent");
            asm volatile("s_waitcnt vmcnt(0)" ::: "memory");
        }
    }
    __syncthreads();
}

constexpr int NPHASE = 14;
#ifndef REP_PH
#define REP_PH -1
#endif
#ifndef REP_SYNC
#define REP_SYNC 1
#endif
#ifndef REP_MODE
#define REP_MODE 0
#endif
#ifndef PHMASK
#define PHMASK 0xFFFFF
#endif
#define EN(x) (((PHMASK) >> (x)) & 1)
__global__ void __launch_bounds__(512, 2) fwd_megakernel(Params p) {
    extern __shared__ __attribute__((aligned(16))) unsigned char smem[];
    LAS unsigned char* lds = (LAS unsigned char*)smem;
    cg::grid_group grid = cg::this_grid();
    unsigned char* ws = p.ws;
    const int G = (int)gridDim.x, bid = (int)blockIdx.x;
    if (threadIdx.x < 2) *(LAS unsigned*)(lds + LDS_SLOT + 16 + 4 * threadIdx.x) = 0u;
    __syncthreads();
    const XcdBarrier xb = xcd_barrier_post((unsigned*)(ws + OFF_BAR), (volatile LAS unsigned*)(lds + LDS_SLOT + 16));
    if (p.ph_lo < 0) grid.sync();
    for (int ph = p.ph_lo; ph < p.ph_hi; ++ph) {
      for (int rep = 0; rep < ((ph == REP_PH) ? 2 : 1); ++rep) {
        GemmDesc gd; gd.M = 0; gd.R = nullptr; gd.rope = nullptr; gd.G = G; gd.c = bid; gd.rbf = 0; gd.order = 0; gd.pad2 = 0; gd.aux = nullptr; gd.mode = 0; gd.A = nullptr; gd.Bt = nullptr; gd.C = nullptr; gd.N = 0; gd.K = 0; gd.ldc = 0;
        switch (ph) {
        case 0: if (EN(0)) prep_phase(p, smem); break;
        case 1: gd.A = (const bf16_t*)(ws + OFF_B1); gd.Bt = (const bf16_t*)(ws + OFF_WIN); gd.C = ws + OFF_H; gd.rope = (const float*)(ws + OFF_ROPE); gd.aux = (float*)(ws + OFF_EB); gd.M = T_TOK; gd.N = HC; gd.K = DM; gd.ldc = HC; gd.mode = 1; break;
        case 2:
            if (bid < 64) { if (EN(1) && !(rep == 1 && REP_MODE == 2)) gla_item(p, bid, lds); }
            else if (bid < 128 && !(rep == 1 && REP_MODE != 0)) { gd.A = (const bf16_t*)(ws + OFF_MEMB); gd.Bt = (const bf16_t*)(ws + OFF_WKV); gd.C = ws + OFF_MKV; gd.M = 1024; gd.N = 4096; gd.K = DM; gd.ldc = 4096; gd.mode = 0; gd.G = 64; gd.c = bid - 64; }
            break;
        case 3: if (EN(2)) merge_phase(p); break;
        case 4: gd.A = (const bf16_t*)(ws + OFF_B1); gd.Bt = (const bf16_t*)(ws + OFF_WOUT); gd.C = ws + OFF_MIX4; gd.M = T_TOK; gd.N = DM; gd.K = DM; gd.ldc = DM; gd.mode = 0; break;
        case 5: if (EN(3)) ln_phase2((const bf16_t*)(ws + OFF_MIX4), p.x, nullptr, p.ln1_g, p.ln1_b, (bf16_t*)(ws + OFF_X1B), nullptr); break;
        case 6: gd.A = (const bf16_t*)(ws + OFF_X1B); gd.Bt = (const bf16_t*)(ws + OFF_WQ); gd.C = ws + OFF_B1; gd.M = T_TOK; gd.N = DM; gd.K = DM; gd.ldc = DM; gd.mode = 0; gd.order = 1; break;
        case 7: break;
        case 8: gd.A = (const bf16_t*)(ws + OFF_OC); gd.Bt = (const bf16_t*)(ws + OFF_WO); gd.C = ws + OFF_MIX8; gd.M = T_TOK; gd.N = DM; gd.K = DM; gd.ldc = DM; gd.mode = 0; break;
        case 9: if (EN(3)) ln_phase2((const bf16_t*)(ws + OFF_MIX8), nullptr, (const bf16_t*)(ws + OFF_X1B), p.ln2_g, p.ln2_b, (bf16_t*)(ws + OFF_B1), nullptr); if (EN(5)) ffn_weights(p, smem); break;
        case 10: gd.A = (const bf16_t*)(ws + OFF_B1); gd.Bt = (const bf16_t*)(ws + OFF_WF1); gd.C = ws + OFF_G; gd.R = p.conv_w; gd.rope = p.conv_b; gd.aux = (float*)(ws + OFF_U);
            gd.M = T_TOK; gd.N = 11008; gd.K = DM; gd.ldc = DFF; gd.mode = 3; break;
        case 11: if (EN(6)) conv_fixup(p); break;
        case 12: gd.A = (const bf16_t*)(ws + OFF_G); gd.Bt = (const bf16_t*)(ws + OFF_WF2); gd.C = ws + OFF_MIX12; gd.M = T_TOK; gd.N = DM; gd.K = DFF; gd.ldc = DM; gd.mode = 0; break;
        case 13: if (EN(3)) ln_phase2((const bf16_t*)(ws + OFF_MIX12), nullptr, (const bf16_t*)(ws + OFF_B1), p.ln3_g, p.ln3_b, nullptr, p.out); break;
        default: break;
        }
        if (EN(7)) if (gd.M) gemm_phase(lds, gd);
        if (ph == 6 && EN(4)) {
            if (threadIdx.x == 0) { __builtin_amdgcn_fence(__ATOMIC_ACQUIRE, "agent"); asm volatile("s_waitcnt vmcnt(0)" ::: "memory"); }
            __syncthreads();
            cross_items(p, lds);
        }
        if (ph == 10 && rep == 0 && bid >= 192) wt_run(p, 1, 1376 + (bid - 192), 64, 1376 + 688, smem);
        if (ph == 2 && !(rep == 1 && REP_MODE == 1)) {
            unsigned* ctr = (unsigned*)(ws + OFF_CTR) + rep;
            if (EN(8)) {
                if (threadIdx.x == 0) *(LAS int*)(lds + LDS_SLOT) = (int)atomicAdd(ctr, 1u);
                __syncthreads();
                int item = *(LAS int*)(lds + LDS_SLOT);
                __syncthreads();
                if (item < 3072) {
                    u32x4 pk[8], pv[8];
                    dil_preload(p, item, opaque_tid(), pk, pv);
                    while (item < 3072) {
                        if (threadIdx.x == 0) *(LAS int*)(lds + LDS_SLOT) = (int)atomicAdd(ctr, 1u);
                        LDS_BARRIER();
                        const int next = *(LAS int*)(lds + LDS_SLOT);
                        dilated_item(p, item, next, pk, pv, lds);
                        item = next;
                    }
                }
                asm volatile("s_waitcnt vmcnt(0)" ::: "memory");
                __syncthreads();
            }
            if (rep == 0) wt_fill(p, ctr + 4, smem, lds);
        }
      }
        if (ph + 1 < p.ph_hi && ph != 6) { for (int r = 0; r < REP_SYNC; ++r) xcd_barrier(xb); }
    }
}

extern "C" void kernel_launch(void* const* d_in, const int* in_sizes, int n_in, void* d_out, int out_size, void* d_ws, size_t ws_size, hipStream_t stream) {
    static int grid_blocks = 0;
    if (grid_blocks == 0) {
        if (ws_size < WS_NEED) { fprintf(stderr, "kernel_launch: workspace too small: %zu < %zu\n", ws_size, (size_t)WS_NEED); grid_blocks = -1; return; }
        int dev = 0, cus = 0, per_cu = 0;
        hipGetDevice(&dev);
        hipDeviceGetAttribute(&cus, hipDeviceAttributeMultiprocessorCount, dev);
        if (hipFuncSetAttribute((const void*)fwd_megakernel, hipFuncAttributeMaxDynamicSharedMemorySize, LDS_BYTES) != hipSuccess) { fprintf(stderr, "kernel_launch: hipFuncSetAttribute failed\n"); grid_blocks = -1; return; }
        hipOccupancyMaxActiveBlocksPerMultiprocessor(&per_cu, (const void*)fwd_megakernel, 512, LDS_BYTES);
        if (per_cu < 1) { fprintf(stderr, "kernel_launch: occupancy query says %d blocks per CU\n", per_cu); per_cu = 1; }
        if (per_cu > 1) per_cu = 1;
        grid_blocks = cus * per_cu;
        fprintf(stderr, "kernel_launch: grid %d (cus %d), ws %zu\n", grid_blocks, cus, ws_size);
    }
    if (grid_blocks < 0) return;
    Params p{};
    p.x = (const float*)d_in[0]; p.mem = (const float*)d_in[1]; p.pos = (const int*)d_in[2]; p.w_in = (const float*)d_in[3]; p.gate_w2 = (const float*)d_in[4]; p.gate_b = (const float*)d_in[5];
    p.norm_g = (const float*)d_in[6]; p.w_out = (const float*)d_in[7]; p.ln1_g = (const float*)d_in[8]; p.ln1_b = (const float*)d_in[9]; p.ca_wq = (const float*)d_in[10]; p.ca_wkv = (const float*)d_in[11];
    p.ca_wo = (const float*)d_in[12]; p.ln2_g = (const float*)d_in[13]; p.ln2_b = (const float*)d_in[14]; p.ffn_w_in = (const float*)d_in[15]; p.conv_w = (const float*)d_in[16]; p.conv_b = (const float*)d_in[17];
    p.ffn_w_out = (const float*)d_in[18]; p.ln3_g = (const float*)d_in[19]; p.ln3_b = (const float*)d_in[20];
    p.out = (float*)d_out; p.ws = (unsigned char*)d_ws;
#if ONE_LAUNCH
    if (hipMemsetAsync((unsigned char*)d_ws + OFF_BAR, 0, XCD_BAR_WORDS * 4, stream) != hipSuccess) { fprintf(stderr, "kernel_launch: memset of barrier words failed\n"); return; }
    p.ph_lo = 0; p.ph_hi = NPHASE;
    void* args[] = {&p};
    hipError_t e = hipLaunchCooperativeKernel((void*)fwd_megakernel, dim3(grid_blocks), dim3(512), args, LDS_BYTES, stream);
    if (e != hipSuccess) fprintf(stderr, "cooperative launch failed: %s (grid %d)\n", hipGetErrorString(e), grid_blocks);
#else
    for (int ph = 0; ph < NPHASE; ++ph) {
        p.ph_lo = ph; p.ph_hi = ph + 1;
        hipLaunchKernelGGL(fwd_megakernel, dim3(grid_blocks), dim3(512), LDS_BYTES, stream, p);
    }
#endif
}
```
